# Optimizing an MI355X kernel written in HIP

```python
import math
import jax, jax.numpy as jnp
from jax import lax
import numpy as np

D_MODEL = 1024
BATCH = 2
SEQ = 8192
DEPTH = 1

ROPE_THETA = 500000.0
NORM_EPS = 1e-6
BLOCK_Q = 128
MLA_HEADS = 8
MLA_NOPE_DIM = 64
MLA_ROPE_DIM = 32
MLA_QK_DIM = MLA_NOPE_DIM + MLA_ROPE_DIM
MLA_V_DIM = 64
MLA_Q_RANK = 384
MLA_KV_RANK = 256
MLA_WIDTH = MLA_HEADS * MLA_V_DIM
DIFF_HEADS = 4
DIFF_HEAD_DIM = 64
DIFF_V_DIM = 2 * DIFF_HEAD_DIM
DIFF_ROT_DIM = DIFF_HEAD_DIM // 4
DIFF_QK_WIDTH = DIFF_HEADS * 2 * DIFF_HEAD_DIM
DIFF_WIDTH = DIFF_HEADS * DIFF_V_DIM
N_BRANCHES = 2
IN_SIZES = (MLA_Q_RANK, MLA_KV_RANK, MLA_ROPE_DIM, DIFF_QK_WIDTH, DIFF_QK_WIDTH, DIFF_WIDTH, N_BRANCHES * D_MODEL)
IN_WIDTH = MLA_Q_RANK + MLA_KV_RANK + MLA_ROPE_DIM + 2 * DIFF_QK_WIDTH + DIFF_WIDTH + N_BRANCHES * D_MODEL
FFN_HIDDEN = ((-(-8 * D_MODEL // 3) + 255) // 256) * 256

kernel_name = "hybrid_mla_diffattn_gated_block"


def rmsnorm(x, g):
    xf = x.astype(jnp.float32)
    y = xf * lax.rsqrt(jnp.mean(xf * xf, axis=-1, keepdims=True) + NORM_EPS)
    return (y * g.astype(jnp.float32)).astype(x.dtype)


def apply_rope(x, positions, rot_dim):
    half = rot_dim // 2
    inv_freq = jnp.exp(-math.log(ROPE_THETA) * jnp.arange(half, dtype=jnp.float32) * (2.0 / rot_dim))
    ang = positions.astype(jnp.float32)[..., None] * inv_freq
    ang = ang.reshape(ang.shape[:2] + (1,) * (x.ndim - 3) + (half,))
    cos, sin = jnp.cos(ang), jnp.sin(ang)
    xr = x[..., :rot_dim].astype(jnp.float32)
    x1, x2 = xr[..., :half], xr[..., half:]
    rot = jnp.concatenate([x1 * cos - x2 * sin, x2 * cos + x1 * sin], axis=-1).astype(x.dtype)
    return jnp.concatenate([rot, x[..., rot_dim:]], axis=-1)


def causal_attention(q, k, v):
    B, S, H, Dk = q.shape
    Dv = v.shape[-1]
    nb = S // BLOCK_Q
    scale = Dk ** -0.5
    qb = q.reshape(B, nb, BLOCK_Q, H, Dk).transpose(1, 0, 2, 3, 4)
    kpos = jnp.arange(S)

    def one_block(args):
        qi, i = args
        s = jnp.einsum('bqhd,bkhd->bhqk', qi, k).astype(jnp.float32) * scale
        qpos = i * BLOCK_Q + jnp.arange(BLOCK_Q)
        s = jnp.where(kpos[None, :] <= qpos[:, None], s, -jnp.inf)
        p = jax.nn.softmax(s, axis=-1).astype(v.dtype)
        return jnp.einsum('bhqk,bkhd->bqhd', p, v)

    out = lax.map(one_block, (qb, jnp.arange(nb)))
    return out.transpose(1, 0, 2, 3, 4).reshape(B, S, H, Dv)


def setup_inputs(seed: int = 0) -> dict:
    key = jax.random.key(seed)
    ks = jax.random.split(key, 24)

    def dense(k, fan_in, fan_out):
        return jax.random.normal(k, (DEPTH, fan_in, fan_out), jnp.float32) * fan_in ** -0.5

    def gain(k, n):
        return 1.0 + 0.02 * jax.random.normal(k, (DEPTH, n), jnp.float32)

    def small(k, n, s):
        return s * jax.random.normal(k, (DEPTH, n), jnp.float32)

    x = jax.random.normal(ks[0], (BATCH, SEQ, D_MODEL), jnp.float32)
    positions = jnp.broadcast_to(jnp.arange(SEQ, dtype=jnp.int32)[None, :], (BATCH, SEQ))
    return {
        "x": x,
        "positions": positions,
        "norm_mix_g": gain(ks[1], D_MODEL),
        "w_in": dense(ks[2], D_MODEL, IN_WIDTH),
        "b_gate": small(ks[3], N_BRANCHES * D_MODEL, 0.1),
        "mla_q_norm_g": gain(ks[4], MLA_Q_RANK),
        "mla_w_uq": dense(ks[5], MLA_Q_RANK, MLA_HEADS * MLA_QK_DIM),
        "mla_kv_norm_g": gain(ks[6], MLA_KV_RANK),
        "mla_w_ukv": dense(ks[7], MLA_KV_RANK, MLA_HEADS * (MLA_NOPE_DIM + MLA_V_DIM)),
        "diff_lambda_q1": small(ks[8], DIFF_HEAD_DIM, 0.1),
        "diff_lambda_k1": small(ks[9], DIFF_HEAD_DIM, 0.1),
        "diff_lambda_q2": small(ks[10], DIFF_HEAD_DIM, 0.1),
        "diff_lambda_k2": small(ks[11], DIFF_HEAD_DIM, 0.1),
        "diff_subln_g": gain(ks[12], DIFF_V_DIM),
        "w_branch_mla": dense(ks[13], MLA_WIDTH, D_MODEL),
        "w_branch_diff": dense(ks[14], DIFF_WIDTH, D_MODEL),
        "w_out": dense(ks[15], D_MODEL, D_MODEL),
        "norm_ffn_g": gain(ks[16], D_MODEL),
        "w_ffn_gate": dense(ks[17], D_MODEL, FFN_HIDDEN),
        "w_ffn_up": dense(ks[18], D_MODEL, FFN_HIDDEN),
        "w_ffn_down": dense(ks[19], FFN_HIDDEN, D_MODEL),
        "norm_final_g": 1.0 + 0.02 * jax.random.normal(ks[20], (D_MODEL,), jnp.float32),
    }


def reference(x, positions, norm_mix_g, w_in, b_gate, mla_q_norm_g, mla_w_uq, mla_kv_norm_g, mla_w_ukv,
              diff_lambda_q1, diff_lambda_k1, diff_lambda_q2, diff_lambda_k2, diff_subln_g,
              w_branch_mla, w_branch_diff, w_out, norm_ffn_g, w_ffn_gate, w_ffn_up, w_ffn_down, norm_final_g):
    B, S, _ = x.shape
    split_idx = [int(v) for v in np.cumsum(IN_SIZES)[:-1]]
    for l in range(DEPTH):
        xn = rmsnorm(x, norm_mix_g[l])
        proj = jnp.einsum('bsd,de->bse', xn, w_in[l])
        q_lat, kv_lat, k_rope, dq, dk, dv, gate_pre = jnp.split(proj, split_idx, axis=-1)

        q = jnp.einsum('bsr,re->bse', rmsnorm(q_lat, mla_q_norm_g[l]), mla_w_uq[l])
        q = q.reshape(B, S, MLA_HEADS, MLA_QK_DIM)
        q_nope, q_pe = q[..., :MLA_NOPE_DIM], apply_rope(q[..., MLA_NOPE_DIM:], positions, MLA_ROPE_DIM)
        kv = jnp.einsum('bsr,re->bse', rmsnorm(kv_lat, mla_kv_norm_g[l]), mla_w_ukv[l])
        kv = kv.reshape(B, S, MLA_HEADS, MLA_NOPE_DIM + MLA_V_DIM)
        k_nope, v_mla = kv[..., :MLA_NOPE_DIM], kv[..., MLA_NOPE_DIM:]
        k_pe = apply_rope(k_rope[:, :, None, :], positions, MLA_ROPE_DIM)
        q_mla = jnp.concatenate([q_nope, q_pe], axis=-1)
        k_mla = jnp.concatenate([k_nope, jnp.broadcast_to(k_pe, (B, S, MLA_HEADS, MLA_ROPE_DIM))], axis=-1)
        o_mla = causal_attention(q_mla, k_mla, v_mla).reshape(B, S, MLA_WIDTH)

        dq = apply_rope(dq.reshape(B, S, DIFF_HEADS, 2, DIFF_HEAD_DIM), positions, DIFF_ROT_DIM)
        dk = apply_rope(dk.reshape(B, S, DIFF_HEADS, 2, DIFF_HEAD_DIM), positions, DIFF_ROT_DIM)
        dv = dv.reshape(B, S, DIFF_HEADS, DIFF_V_DIM)
        o1 = causal_attention(dq[..., 0, :], dk[..., 0, :], dv)
        o2 = causal_attention(dq[..., 1, :], dk[..., 1, :], dv)
        lambda_init = 0.8 - 0.6 * math.exp(-0.3 * l)
        lam = (jnp.exp(jnp.sum(diff_lambda_q1[l].astype(jnp.float32) * diff_lambda_k1[l].astype(jnp.float32)))
               - jnp.exp(jnp.sum(diff_lambda_q2[l].astype(jnp.float32) * diff_lambda_k2[l].astype(jnp.float32)))
               + lambda_init).astype(o1.dtype)
        o_diff = rmsnorm(o1 - lam * o2, diff_subln_g[l]) * (1.0 - lambda_init)
        o_diff = o_diff.reshape(B, S, DIFF_WIDTH)

        gates = jax.nn.sigmoid(gate_pre + b_gate[l])
        g_mla, g_diff = gates[..., :D_MODEL], gates[..., D_MODEL:]
        merged = (g_mla * jnp.einsum('bse,ed->bsd', o_mla, w_branch_mla[l])
                  + g_diff * jnp.einsum('bse,ed->bsd', o_diff, w_branch_diff[l]))
        x = x + jnp.einsum('bsd,de->bse', merged, w_out[l])

        hn = rmsnorm(x, norm_ffn_g[l])
        hid = jax.nn.silu(jnp.einsum('bsd,df->bsf', hn, w_ffn_gate[l])) * jnp.einsum('bsd,df->bsf', hn, w_ffn_up[l])
        x = x + jnp.einsum('bsf,fd->bsd', hid, w_ffn_down[l])
    return rmsnorm(x, norm_final_g)
```

```cpp
#include <hip/hip_runtime.h>
#include <hip/hip_cooperative_groups.h>
#include <cstdio>
#include <cstdint>
namespace cg = cooperative_groups;
namespace pg8 {
#define PG8_LAS __attribute__((address_space(3)))
typedef unsigned short bf16_t;
typedef short bf16x8 __attribute__((ext_vector_type(8)));
typedef float f32x4 __attribute__((ext_vector_type(4)));
typedef unsigned u32x4 __attribute__((ext_vector_type(4)));
constexpr int BM = 256, BK = 64, HALF = 128, HTB = HALF * BK * 2  , STAGE_BYTES = 8 * HTB, NXCD = 8, WGM = 8;

__host__ __device__ __forceinline__ int lds_byte(int r, int c) { const int st = (r >> 4) * 2 + (c >> 5), rr = r & 15, cc = c & 31, ob = rr * 64 + cc * 2; return st * 1024 + (ob ^ (((ob >> 9) & 1) << 5)); }
__host__ __device__ __forceinline__ void stage_rc(int b, int& R, int& C) { const int st = b / 1024, sb = b % 1024, swz = sb ^ (((sb >> 9) & 1) << 5); R = (st >> 1) * 16 + swz / 64; C = (st & 1) * 32 + (swz % 64) / 2; }
__host__ __device__ __forceinline__ int perm32(int rho) { const int n = rho >> 4, i = rho & 15; return 8 * (i >> 2) + 4 * n + (i & 3); }

struct Unit { int pm, pn; };
struct Gemm { const bf16_t* A; const bf16_t* Bt; int M, N, K; };

struct StaticOrder {
    int nM, nN, nwg, G, c;
    __host__ __device__ void init(int M, int N, int G_, int c_) { nM = M / BM; nN = N / BM; nwg = nM * nN; G = G_; c = c_; }
    __host__ __device__ bool next(int i, Unit& u) const {
        const long L = (long)i * G + c; if (L >= nwg) return false;
        int wgid = (int)L; { const int q = nwg / NXCD, r = nwg % NXCD, xcd = wgid % NXCD, off = wgid / NXCD; wgid = (xcd < r ? xcd * (q + 1) : r * (q + 1) + (xcd - r) * q) + off; }
        const int nig = WGM * nN, gid = wgid / nig, fm = gid * WGM, gsz = (nM - fm) < WGM ? (nM - fm) : WGM;
        u.pm = fm + ((wgid % nig) % gsz); u.pn = (wgid % nig) / gsz; return true;
    }
    __device__ __forceinline__ void a_ready(const Unit&) const {}
    __device__ __forceinline__ void done(const Unit&) const {}
};

typedef float f32x2_t __attribute__((ext_vector_type(2))); typedef __bf16 bf16x2_t __attribute__((ext_vector_type(2)));
__device__ __forceinline__ unsigned cvt_pk_bf16(float lo, float hi) { f32x2_t v = {lo, hi}; bf16x2_t b = __builtin_convertvector(v, bf16x2_t); return __builtin_bit_cast(unsigned, b); }
typedef float f32x2 __attribute__((ext_vector_type(2)));
template <class Epi, class Sched, bool ALIGN_EPI = false, bool SP2 = false>
__device__ __forceinline__ void gemm_phase(PG8_LAS unsigned char* lds, const Gemm g, const Sched& S, const Epi& E) {
    const int tid = threadIdx.x, wid = __builtin_amdgcn_readfirstlane(tid >> 6), lane = tid & 63, wr = wid >> 2, wc = wid & 3, fr = lane & 15, fq = lane >> 4;
    const int K = g.K, nt = K / BK;
    unsigned voffA[2], voffB[2];
#pragma unroll
    for (int i = 0; i < 2; ++i) { int R, C; stage_rc(tid * 16 + i * 8192, R, C); const int Rb = Epi::PERM ? ((R & ~31) + perm32(R & 31)) : R;
        voffA[i] = (unsigned)(R * K + C) * 2u; voffB[i] = (unsigned)(Rb * K + C) * 2u; }
    const size_t kstep = (size_t)(BK * 2);
    const size_t hstep = (size_t)HALF * K * 2;
    const size_t tstep = 2 * hstep;
    const unsigned ldsw = (unsigned)wid * 1024u;
    const int aoff = lds_byte(wr * 64 + fr, fq * 8), boff = lds_byte(wc * 32 + fr, fq * 8);
#define PG8_SA(b, h) (((b) * 2 + (h)) * HTB)
#define PG8_SB(b, h) ((4 + (b) * 2 + (h)) * HTB)
#define PG8_STAGE(bufoff, gbase, voff) do { _Pragma("unroll") for (int _i = 0; _i < 2; ++_i) \
        __builtin_amdgcn_global_load_lds((const unsigned*)((const char*)(gbase) + (voff)[_i]), (PG8_LAS unsigned*)(lds + (bufoff) + ldsw + _i * 8192), 16, 0, 0); } while (0)
#define PG8_LDA(dst, b, h) do { _Pragma("unroll") for (int m = 0; m < 4; ++m) _Pragma("unroll") for (int k = 0; k < 2; ++k) dst[m][k] = *(const PG8_LAS bf16x8*)(lds + PG8_SA(b, h) + aoff + m * 2048 + k * 1024); } while (0)
#define PG8_LDB(dst, b, h) do { _Pragma("unroll") for (int n = 0; n < 2; ++n) _Pragma("unroll") for (int k = 0; k < 2; ++k) dst[n][k] = *(const PG8_LAS bf16x8*)(lds + PG8_SB(b, h) + boff + n * 2048 + k * 1024); } while (0)
#define PG8_MMA(ai, bj, At, Bt) do { __builtin_amdgcn_s_setprio(1); _Pragma("unroll") for (int m = 0; m < 4; ++m) _Pragma("unroll") for (int n = 0; n < 2; ++n) _Pragma("unroll") for (int k = 0; k < 2; ++k) \
        acc[ai][bj][m][n] = __builtin_amdgcn_mfma_f32_16x16x32_bf16(Bt[n][k], At[m][k], acc[ai][bj][m][n], 0, 0, 0); __builtin_amdgcn_s_setprio(0); } while (0)
#define PG8_WAIT_V(n) asm volatile("s_waitcnt vmcnt(" #n ")" ::: "memory")
#define PG8_WAIT_L(n) asm volatile("s_waitcnt lgkmcnt(" #n ")" ::: "memory")
#define PG8_BAR __builtin_amdgcn_s_barrier()
#define PG8_SCHED __builtin_amdgcn_sched_barrier(0)
    Unit cur, nxt; int ui = 0;
    if (!S.next(0, cur)) return;
    f32x4 acc[2][2][4][2];
#pragma unroll
    for (int a = 0; a < 2; ++a)
#pragma unroll
        for (int b = 0; b < 2; ++b)
#pragma unroll
            for (int m = 0; m < 4; ++m)
#pragma unroll
                for (int n = 0; n < 2; ++n) acc[a][b][m][n] = (f32x4){0.f, 0.f, 0.f, 0.f};
    bf16x8 At[4][2], B0[2][2], B1[2][2];
    const char* cA = (const char*)g.A + (size_t)cur.pm * tstep; const char* cB = (const char*)g.Bt + (size_t)cur.pn * tstep;
    S.a_ready(cur);
    if constexpr (SP2) {
        PG8_STAGE(PG8_SB(0, 0), cB, voffB); PG8_STAGE(PG8_SB(0, 1), cB + hstep, voffB); PG8_STAGE(PG8_SA(0, 0), cA, voffA); PG8_STAGE(PG8_SA(0, 1), cA + hstep, voffA);
        if (wr == 1) PG8_BAR;
        PG8_WAIT_V(2); PG8_BAR;
        PG8_STAGE(PG8_SB(1, 0), cB + kstep, voffB); PG8_STAGE(PG8_SA(1, 0), cA + kstep, voffA); PG8_STAGE(PG8_SB(1, 1), cB + hstep + kstep, voffB);
        PG8_WAIT_V(6); PG8_BAR;
    } else {
        PG8_STAGE(PG8_SB(0, 0), cB, voffB); PG8_STAGE(PG8_SA(0, 0), cA, voffA); PG8_STAGE(PG8_SB(0, 1), cB + hstep, voffB); PG8_STAGE(PG8_SA(0, 1), cA + hstep, voffA);
        if (wr == 1) PG8_BAR;
        PG8_WAIT_V(4); PG8_BAR;
        PG8_STAGE(PG8_SB(1, 0), cB + kstep, voffB); PG8_STAGE(PG8_SA(1, 0), cA + kstep, voffA); PG8_STAGE(PG8_SB(1, 1), cB + hstep + kstep, voffB);
        PG8_WAIT_V(6); PG8_BAR;
    }
    for (;;) {
        const bool has_next = S.next(ui + 1, nxt);
        const char* nA = has_next ? (const char*)g.A + (size_t)nxt.pm * tstep : cA; const char* nB = has_next ? (const char*)g.Bt + (size_t)nxt.pn * tstep : cB;
#pragma unroll 1
        for (int t = 0; t < nt; t += 2) {
            const bool last = (t == nt - 2);
            const char* a1 = cA + (size_t)(t + 1) * kstep;
            const char* a2 = last ? nA : cA + (size_t)(t + 2) * kstep; const char* b2 = last ? nB : cB + (size_t)(t + 2) * kstep;
            const char* a3 = a2 + kstep; const char* b3 = b2 + kstep;
            if (last && has_next) S.a_ready(nxt);
            if constexpr (SP2) {
            PG8_LDB(B0, 0, 0); PG8_LDB(B1, 0, 1); PG8_SCHED; PG8_LDA(At, 0, 0); PG8_STAGE(PG8_SA(1, 1), a1 + hstep, voffA);
            PG8_WAIT_V(8); PG8_WAIT_L(0); PG8_BAR; PG8_MMA(0, 0, At, B0); PG8_MMA(0, 1, At, B1); PG8_BAR; PG8_SCHED;
            PG8_LDA(At, 0, 1); PG8_STAGE(PG8_SB(0, 0), b2, voffB); PG8_STAGE(PG8_SB(0, 1), b2 + hstep, voffB); PG8_STAGE(PG8_SA(0, 0), a2, voffA);
            PG8_WAIT_V(8); PG8_WAIT_L(0); PG8_BAR; PG8_MMA(1, 0, At, B0); PG8_MMA(1, 1, At, B1); PG8_BAR; PG8_SCHED;
            PG8_LDB(B0, 1, 0); PG8_LDB(B1, 1, 1); PG8_SCHED; PG8_LDA(At, 1, 0); PG8_STAGE(PG8_SA(0, 1), a2 + hstep, voffA);
            PG8_WAIT_V(8); PG8_WAIT_L(0); PG8_BAR; PG8_MMA(0, 0, At, B0); PG8_MMA(0, 1, At, B1); PG8_BAR; PG8_SCHED;
            PG8_LDA(At, 1, 1); PG8_STAGE(PG8_SB(1, 0), b3, voffB); PG8_STAGE(PG8_SB(1, 1), b3 + hstep, voffB); PG8_STAGE(PG8_SA(1, 0), a3, voffA);
            PG8_WAIT_V(8); PG8_WAIT_L(0); PG8_BAR; PG8_MMA(1, 0, At, B0); PG8_MMA(1, 1, At, B1); PG8_BAR; PG8_SCHED;
            } else {
            PG8_LDB(B0, 0, 0); PG8_SCHED; PG8_LDA(At, 0, 0); PG8_STAGE(PG8_SA(1, 1), a1 + hstep, voffA);
            PG8_WAIT_L(8); PG8_BAR; PG8_WAIT_L(0); PG8_MMA(0, 0, At, B0); PG8_BAR; PG8_SCHED;
            PG8_LDB(B1, 0, 1); PG8_STAGE(PG8_SB(0, 0), b2, voffB);
            PG8_BAR; PG8_WAIT_L(0); PG8_MMA(0, 1, At, B1); PG8_BAR;
            PG8_LDA(At, 0, 1); PG8_STAGE(PG8_SA(0, 0), a2, voffA);
            PG8_BAR; PG8_WAIT_L(0); PG8_MMA(1, 0, At, B0); PG8_BAR; PG8_SCHED;
            PG8_STAGE(PG8_SB(0, 1), b2 + hstep, voffB);
            PG8_WAIT_V(6); PG8_BAR; PG8_MMA(1, 1, At, B1); PG8_BAR;
            PG8_LDB(B0, 1, 0); PG8_SCHED; PG8_LDA(At, 1, 0); PG8_STAGE(PG8_SA(0, 1), a2 + hstep, voffA);
            PG8_WAIT_L(8); PG8_BAR; PG8_WAIT_L(0); PG8_MMA(0, 0, At, B0); PG8_BAR; PG8_SCHED;
            PG8_LDB(B1, 1, 1); PG8_STAGE(PG8_SB(1, 0), b3, voffB);
            PG8_BAR; PG8_WAIT_L(0); PG8_MMA(0, 1, At, B1); PG8_BAR;
            PG8_LDA(At, 1, 1); PG8_STAGE(PG8_SA(1, 0), a3, voffA);
            PG8_BAR; PG8_WAIT_L(0); PG8_MMA(1, 0, At, B0); PG8_BAR; PG8_SCHED;
            PG8_STAGE(PG8_SB(1, 1), b3 + hstep, voffB);
            PG8_WAIT_V(6); PG8_BAR; PG8_MMA(1, 1, At, B1); PG8_BAR;
            }
        }
        if constexpr (ALIGN_EPI) { if (wr == 0) PG8_BAR; }
        if constexpr (!Epi::AFTER_DRAIN) { E(acc, cur, wr, wc, fr, fq); S.done(cur); }
        if (!has_next) break;
#pragma unroll
        for (int a = 0; a < 2; ++a)
#pragma unroll
            for (int b = 0; b < 2; ++b)
#pragma unroll
                for (int m = 0; m < 4; ++m)
#pragma unroll
                    for (int n = 0; n < 2; ++n) acc[a][b][m][n] = (f32x4){0.f, 0.f, 0.f, 0.f};
        cur = nxt; cA = nA; cB = nB; ++ui;
        if constexpr (ALIGN_EPI) { if (wr == 1) PG8_BAR; }
    }
    PG8_WAIT_V(0);
    if constexpr (!ALIGN_EPI) { if (wr == 0) PG8_BAR; }
    PG8_BAR;
    if constexpr (Epi::AFTER_DRAIN) { E.fused(acc, cur, wr, wc, fr, fq, lds, wid, lane); S.done(cur); }
#undef PG8_SA
#undef PG8_SB
#undef PG8_STAGE
#undef PG8_LDA
#undef PG8_LDB
#undef PG8_MMA
#undef PG8_WAIT_V
#undef PG8_WAIT_L
#undef PG8_BAR
#undef PG8_SCHED
}
}

#ifndef PH_MASK
#define PH_MASK 0xFFFF
#endif
#define PH(k) ((PH_MASK >> (k)) & 1)
constexpr int NB = 2, SEQ = 8192, M = NB * SEQ, D = 1024;
constexpr int N1 = 4352;
constexpr int FF = 2816;
constexpr float EPS = 1e-6f;
constexpr float LOG2E = 1.4426950408889634f;
constexpr float QS_M = 0.10206207261596577f * LOG2E;
constexpr float QS_D = 0.125f * LOG2E;
constexpr float LAMBDA_INIT = 0.2f;

constexpr size_t MiB = 1u << 20;
constexpr size_t WS_SS = 0;
constexpr size_t WS_TAB = 1 * MiB;
constexpr size_t WS_W1 = 4 * MiB, WS_W2A = 13 * MiB, WS_W2B = 14 * MiB, WS_W3A = 15 * MiB, WS_W3B = 16 * MiB, WS_W4 = 17 * MiB, WS_W5 = 19 * MiB, WS_W6 = 30 * MiB;
constexpr size_t WS_XN = 36 * MiB, WS_QL = 68 * MiB, WS_KVL = 80 * MiB;
constexpr size_t WS_OM = 36 * MiB, WS_ODR = 52 * MiB;
constexpr size_t WS_QD = 88 * MiB, WS_ODN = 88 * MiB;
constexpr size_t WS_KD = 104 * MiB, WS_VDT = 120 * MiB, WS_MERGED = 104 * MiB;
constexpr size_t WS_QM = 136 * MiB, WS_KM = 160 * MiB, WS_VMT = 184 * MiB, WS_TMP = 136 * MiB;
constexpr size_t WS_X1B = 200 * MiB;
constexpr size_t WS_H = 36 * MiB;
constexpr size_t WS_PART = 232 * MiB;
constexpr size_t WS_END = 236 * MiB;

constexpr int LDS_BYTES = 147456;

#define LAS __attribute__((address_space(3)))
typedef unsigned short bf16;
typedef unsigned v4u __attribute__((ext_vector_type(4)));
typedef unsigned v2u __attribute__((ext_vector_type(2)));
typedef float f32x4 __attribute__((ext_vector_type(4)));
typedef float f32x16 __attribute__((ext_vector_type(16)));
typedef short bf16x8 __attribute__((ext_vector_type(8)));
using pg8::cvt_pk_bf16;
#define LDS_WAIT() asm volatile("s_waitcnt lgkmcnt(0)" ::: "memory")
__device__ __forceinline__ unsigned f2bf(float f) { unsigned u = __builtin_bit_cast(unsigned, f); return (u + 0x7fffu + ((u >> 16) & 1u)) >> 16; }
__device__ __forceinline__ unsigned pk2(float lo, float hi) { return f2bf(lo) | (f2bf(hi) << 16); }
__device__ __forceinline__ float bf2f(unsigned h) { return __builtin_bit_cast(float, h << 16); }
__device__ __forceinline__ float wave_sum(float v) {
#pragma unroll
    for (int o = 1; o < 64; o <<= 1) v += __shfl_xor(v, o);
    return v;
}
__device__ __forceinline__ int p16(int k) { return ((k >> 2) & 1) * 8 + (k >> 3) * 4 + (k & 3); }
__device__ __forceinline__ float sigmoidf_(float v) { return __builtin_amdgcn_rcpf(1.f + __builtin_amdgcn_exp2f(-v * LOG2E)); }
__device__ __forceinline__ v2u pack4(f32x4 v) { v2u r; r.x = cvt_pk_bf16(v[0], v[1]); r.y = cvt_pk_bf16(v[2], v[3]); return r; }
__device__ __forceinline__ v4u pack8(f32x4 a, f32x4 b) { v4u r; r.x = cvt_pk_bf16(a[0], a[1]); r.y = cvt_pk_bf16(a[2], a[3]); r.z = cvt_pk_bf16(b[0], b[1]); r.w = cvt_pk_bf16(b[2], b[3]); return r; }

using pg8::Unit;
struct EpiInProj {
    static constexpr bool PERM = true, AFTER_DRAIN = false;
    bf16 *Qd, *Kd, *VdT, *GATES, *QL, *KVL, *Km; const float *bgate, *tdc, *tds, *tmc, *tms; float *ssq, *sskv;
    __device__ __forceinline__ void operator()(const f32x4 (&acc)[2][2][4][2], const Unit& u, int wr, int wc, int fr, int fq) const {
        const int pn = u.pn; const int row0 = u.pm * 256 + wr * 64 + fr;
        if (pn < 4) {
            bf16* dst = pn < 2 ? Qd : Kd; const float sc = pn < 2 ? QS_D : 1.f; const int cb = (pn & 1) * 256 + wc * 32 + 8 * fq;
            const bool rope = (wc & 1) == 0;
#pragma unroll
            for (int ai = 0; ai < 2; ++ai)
#pragma unroll
                for (int m = 0; m < 4; ++m) {
                    const int row = row0 + ai * 128 + m * 16;
                    f32x4 c0 = {1.f, 1.f, 1.f, 1.f}, c1 = c0, s0 = {0.f, 0.f, 0.f, 0.f}, s1 = s0;
                    if (rope) { c0 = *(const f32x4*)(tdc + (size_t)row * 8); c1 = *(const f32x4*)(tdc + (size_t)row * 8 + 4); s0 = *(const f32x4*)(tds + (size_t)row * 8); s1 = *(const f32x4*)(tds + (size_t)row * 8 + 4); }
#pragma unroll
                    for (int bj = 0; bj < 2; ++bj) {
                        f32x4 v0 = acc[ai][bj][m][0], v1 = acc[ai][bj][m][1];
                        if (rope) {
#pragma unroll
                            for (int j = 0; j < 4; ++j) {
                                const float p0 = __shfl_xor(v0[j], 16), p1 = __shfl_xor(v1[j], 16);
                                if (fq == 0) { v0[j] = v0[j] * c0[j] - p0 * s0[j]; v1[j] = v1[j] * c1[j] - p1 * s1[j]; }
                                else if (fq == 1) { v0[j] = v0[j] * c0[j] + p0 * s0[j]; v1[j] = v1[j] * c1[j] + p1 * s1[j]; }
                            }
                        }
                        v0 = v0 * sc; v1 = v1 * sc;
                        *(v4u*)(dst + (size_t)row * 512 + cb + bj * 128) = pack8(v0, v1);
                    }
                }
        } else if (pn < 6) {
#pragma unroll
            for (int ai = 0; ai < 2; ++ai)
#pragma unroll
                for (int m = 0; m < 4; ++m) {
                    const int row = row0 + ai * 128 + m * 16; const int b = row >> 13, pos = row & (SEQ - 1), pp = (pos & ~15) | p16(pos & 15);
#pragma unroll
                    for (int bj = 0; bj < 2; ++bj) {
                        const int h = (pn - 4) * 2 + bj;
                        bf16* base = VdT + ((size_t)((b * 4 + h) * 128 + wc * 32 + 8 * fq)) * SEQ + pp;
#pragma unroll
                        for (int n = 0; n < 2; ++n)
#pragma unroll
                            for (int j = 0; j < 4; ++j) base[(size_t)(4 * n + j) * SEQ] = (bf16)f2bf(acc[ai][bj][m][n][j]);
                    }
                }
        } else if (pn < 14) {
            const int cb = (pn - 6) * 256 + wc * 32 + 8 * fq;
            f32x4 bv[2][2];
#pragma unroll
            for (int bj = 0; bj < 2; ++bj) { bv[bj][0] = *(const f32x4*)(bgate + cb + bj * 128); bv[bj][1] = *(const f32x4*)(bgate + cb + bj * 128 + 4); }
#pragma unroll
            for (int ai = 0; ai < 2; ++ai)
#pragma unroll
                for (int m = 0; m < 4; ++m) {
                    const int row = row0 + ai * 128 + m * 16;
#pragma unroll
                    for (int bj = 0; bj < 2; ++bj) {
                        f32x4 v0 = acc[ai][bj][m][0] + bv[bj][0], v1 = acc[ai][bj][m][1] + bv[bj][1];
#pragma unroll
                        for (int j = 0; j < 4; ++j) { v0[j] = sigmoidf_(v0[j]); v1[j] = sigmoidf_(v1[j]); }
                        *(v4u*)(GATES + (size_t)row * 2048 + cb + bj * 128) = pack8(v0, v1);
                    }
                }
        } else {
#pragma unroll
            for (int bj = 0; bj < 2; ++bj) {
                const int hh = 2 * (pn - 14) + bj;
                if (hh <= 4) {
                    bf16* dst; int ld, cb; float* ss; int sld;
                    if (hh <= 2) { dst = QL; ld = 384; cb = hh * 128; ss = ssq + hh * 4 + wc; sld = 16; } else { dst = KVL; ld = 256; cb = (hh - 3) * 128; ss = sskv + (hh - 3) * 4 + wc; sld = 8; }
                    cb += wc * 32 + 8 * fq;
#pragma unroll
                    for (int ai = 0; ai < 2; ++ai)
#pragma unroll
                        for (int m = 0; m < 4; ++m) {
                            const int row = row0 + ai * 128 + m * 16;
                            const f32x4 v0 = acc[ai][bj][m][0], v1 = acc[ai][bj][m][1];
                            float s = (v0[0] * v0[0] + v0[1] * v0[1]) + (v0[2] * v0[2] + v0[3] * v0[3]) + (v1[0] * v1[0] + v1[1] * v1[1]) + (v1[2] * v1[2] + v1[3] * v1[3]);
                            s += __shfl_xor(s, 16); s += __shfl_xor(s, 32);
                            if (fq == 0) ss[(size_t)row * sld] = s;
                            *(v4u*)(dst + (size_t)row * ld + cb) = pack8(v0, v1);
                        }
                } else if (wc == 0) {
#pragma unroll
                    for (int ai = 0; ai < 2; ++ai)
#pragma unroll
                        for (int m = 0; m < 4; ++m) {
                            const int row = row0 + ai * 128 + m * 16;
                            const f32x4 c0 = *(const f32x4*)(tmc + (size_t)row * 16 + 8 * (fq & 1)), c1 = *(const f32x4*)(tmc + (size_t)row * 16 + 8 * (fq & 1) + 4);
                            const f32x4 s0 = *(const f32x4*)(tms + (size_t)row * 16 + 8 * (fq & 1)), s1 = *(const f32x4*)(tms + (size_t)row * 16 + 8 * (fq & 1) + 4);
                            f32x4 v0 = acc[ai][bj][m][0], v1 = acc[ai][bj][m][1];
#pragma unroll
                            for (int j = 0; j < 4; ++j) {
                                const float p0 = __shfl_xor(v0[j], 32), p1 = __shfl_xor(v1[j], 32);
                                if (fq < 2) { v0[j] = v0[j] * c0[j] - p0 * s0[j]; v1[j] = v1[j] * c1[j] - p1 * s1[j]; }
                                else { v0[j] = v0[j] * c0[j] + p0 * s0[j]; v1[j] = v1[j] * c1[j] + p1 * s1[j]; }
                            }
                            const v4u w = pack8(v0, v1);
#pragma unroll
                            for (int h = 0; h < 8; ++h) *(v4u*)(Km + (size_t)row * 768 + h * 96 + 64 + 8 * fq) = w;
                        }
                }
            }
        }
    }
};
struct EpiQup {
    static constexpr bool PERM = false, AFTER_DRAIN = false;
    bf16* Qm; const float *ssq, *tmc, *tms;
    __device__ __forceinline__ void operator()(const f32x4 (&acc)[2][2][4][2], const Unit& u, int wr, int wc, int fr, int fq) const {
        const int row0 = u.pm * 256 + wr * 64 + fr;
#pragma unroll
        for (int ai = 0; ai < 2; ++ai)
#pragma unroll
            for (int m = 0; m < 4; ++m) {
                const int row = row0 + ai * 128 + m * 16;
                const f32x4 pa = *(const f32x4*)(ssq + (size_t)row * 16), pb = *(const f32x4*)(ssq + (size_t)row * 16 + 4), pc = *(const f32x4*)(ssq + (size_t)row * 16 + 8);
                const float sq = ((pa[0] + pa[1]) + (pa[2] + pa[3])) + ((pb[0] + pb[1]) + (pb[2] + pb[3])) + ((pc[0] + pc[1]) + (pc[2] + pc[3]));
                const float rs = rsqrtf(sq * (1.f / 384.f) + EPS) * QS_M;
#pragma unroll
                for (int bj = 0; bj < 2; ++bj) {
                    const int gi = 8 * u.pn + 4 * bj + wc, part = gi % 3;
                    f32x4 v0 = acc[ai][bj][m][0] * rs, v1 = acc[ai][bj][m][1] * rs;
                    if (part == 2) {
                        const f32x4 c = *(const f32x4*)(tmc + (size_t)row * 16 + 4 * fq), s = *(const f32x4*)(tms + (size_t)row * 16 + 4 * fq);
                        const f32x4 o0 = v0 * c - v1 * s, o1 = v1 * c + v0 * s; v0 = o0; v1 = o1;
                    }
                    bf16* p = Qm + (size_t)row * 768 + 32 * gi + 4 * fq;
                    *(v2u*)p = pack4(v0); *(v2u*)(p + 16) = pack4(v1);
                }
                asm volatile("" ::: "memory");
            }
    }
};
struct EpiKVup {
    static constexpr bool PERM = false, AFTER_DRAIN = false;
    bf16 *Km, *VmT; const float* sskv;
    __device__ __forceinline__ void operator()(const f32x4 (&acc)[2][2][4][2], const Unit& u, int wr, int wc, int fr, int fq) const {
        const int row0 = u.pm * 256 + wr * 64 + fr;
#pragma unroll
        for (int ai = 0; ai < 2; ++ai)
#pragma unroll
            for (int m = 0; m < 4; ++m) {
                const int row = row0 + ai * 128 + m * 16; const int b = row >> 13, pos = row & (SEQ - 1), pp = (pos & ~15) | p16(pos & 15);
                const f32x4 pa = *(const f32x4*)(sskv + (size_t)row * 8), pb = *(const f32x4*)(sskv + (size_t)row * 8 + 4);
                const float rs = rsqrtf((((pa[0] + pa[1]) + (pa[2] + pa[3])) + ((pb[0] + pb[1]) + (pb[2] + pb[3]))) * (1.f / 256.f) + EPS);
#pragma unroll
                for (int bj = 0; bj < 2; ++bj) {
                    const int head = 2 * u.pn + bj;
                    const f32x4 v0 = acc[ai][bj][m][0] * rs, v1 = acc[ai][bj][m][1] * rs;
                    if (wc < 2) {
                        bf16* p = Km + (size_t)row * 768 + head * 96 + 32 * wc + 4 * fq;
                        *(v2u*)p = pack4(v0); *(v2u*)(p + 16) = pack4(v1);
                    } else {
                        bf16* base = VmT + ((size_t)((b * 8 + head) * 64 + 32 * (wc - 2) + 4 * fq)) * SEQ + pp;
#pragma unroll
                        for (int j = 0; j < 4; ++j) { base[(size_t)j * SEQ] = (bf16)f2bf(v0[j]); base[(size_t)(16 + j) * SEQ] = (bf16)f2bf(v1[j]); }
                    }
                }
                asm volatile("" ::: "memory");
            }
    }
};
template <int STEP> struct EpiBranch {
    static constexpr bool PERM = false, AFTER_DRAIN = false;
    const bf16* GATES; float* TMP; bf16* MERGED;
    __device__ __forceinline__ void operator()(const f32x4 (&acc)[2][2][4][2], const Unit& u, int wr, int wc, int fr, int fq) const {
        const int row0 = u.pm * 256 + wr * 64 + fr, col0 = u.pn * 256 + wc * 32 + 4 * fq;
#pragma unroll
        for (int ai = 0; ai < 2; ++ai)
#pragma unroll
            for (int m = 0; m < 4; ++m) {
                const int row = row0 + ai * 128 + m * 16;
#pragma unroll
                for (int bj = 0; bj < 2; ++bj)
#pragma unroll
                    for (int n = 0; n < 2; ++n) {
                        const int col = col0 + bj * 128 + n * 16;
                        const v2u gw = *(const v2u*)(GATES + (size_t)row * 2048 + STEP * 1024 + col);
                        const f32x4 g = {bf2f(gw.x & 0xffffu), bf2f(gw.x >> 16), bf2f(gw.y & 0xffffu), bf2f(gw.y >> 16)};
                        float* tp = TMP + (size_t)row * 1024 + col;
                        if (STEP == 0) *(f32x4*)tp = acc[ai][bj][m][n] * g;
                        else { const f32x4 t = *(const f32x4*)tp; *(v2u*)(MERGED + (size_t)row * 1024 + col) = pack4(t + acc[ai][bj][m][n] * g); }
                    }
            }
    }
};
struct EpiRes {
    static constexpr bool PERM = false, AFTER_DRAIN = false;
    const float* base; float* out; bf16* outb; float* ss;
    __device__ __forceinline__ void operator()(const f32x4 (&acc)[2][2][4][2], const Unit& u, int wr, int wc, int fr, int fq) const {
        const int row0 = u.pm * 256 + wr * 64 + fr, col0 = u.pn * 256 + wc * 32 + 4 * fq;
#pragma unroll
        for (int ai = 0; ai < 2; ++ai)
#pragma unroll
            for (int m = 0; m < 4; ++m) {
                const int row = row0 + ai * 128 + m * 16; float s = 0.f;
#pragma unroll
                for (int bj = 0; bj < 2; ++bj)
#pragma unroll
                    for (int n = 0; n < 2; ++n) {
                        const size_t off = (size_t)row * 1024 + col0 + bj * 128 + n * 16;
                        const f32x4 v = *(const f32x4*)(base + off) + acc[ai][bj][m][n];
                        s += (v[0] * v[0] + v[1] * v[1]) + (v[2] * v[2] + v[3] * v[3]);
                        *(f32x4*)(out + off) = v;
                        if (outb) *(v2u*)(outb + off) = pack4(v);
                    }
                s += __shfl_xor(s, 16); s += __shfl_xor(s, 32);
                if (fq == 0) ss[(size_t)row * 16 + u.pn * 4 + wc] = s;
            }
    }
};
struct EpiSwiglu {
    static constexpr bool PERM = true, AFTER_DRAIN = false;
    bf16* H; const float* ss1;
    __device__ __forceinline__ void operator()(const f32x4 (&acc)[2][2][4][2], const Unit& u, int wr, int wc, int fr, int fq) const {
        const int row0 = u.pm * 256 + wr * 64 + fr, col0 = u.pn * 128 + wc * 32 + 8 * fq;
#pragma unroll
        for (int ai = 0; ai < 2; ++ai)
#pragma unroll
            for (int m = 0; m < 4; ++m) {
                const int row = row0 + ai * 128 + m * 16;
                float sq = 0.f;
#pragma unroll
                for (int k = 0; k < 4; ++k) { const f32x4 p = *(const f32x4*)(ss1 + (size_t)row * 16 + 4 * k); sq += (p[0] + p[1]) + (p[2] + p[3]); }
                const float rs = rsqrtf(sq * (1.f / 1024.f) + EPS);
                f32x4 o[2];
#pragma unroll
                for (int n = 0; n < 2; ++n) {
                    const f32x4 g = acc[ai][0][m][n] * rs, up = acc[ai][1][m][n] * rs;
#pragma unroll
                    for (int j = 0; j < 4; ++j) o[n][j] = g[j] * sigmoidf_(g[j]) * up[j];
                }
                *(v4u*)(H + (size_t)row * FF + col0) = pack8(o[0], o[1]);
            }
    }
};

template <int DK, int DV>
__device__ __forceinline__ void attn_unit(LAS unsigned char* lds, const bf16* Qp, int ldq, const bf16* Kp, int ldk, const bf16* VTp, bf16* Op, int ldo, int qb) {
    constexpr int KC = DK / 8, KP = DK * 2 + 16, VP = 144, KTB = 64 * KP, BUF = KTB + DV * VP;
    constexpr int KCH = 64 * KC, VCH = DV * 8, NKL = (KCH + 511) / 512, NVL = VCH / 512, NDB = DV / 32;
    const int tid = threadIdx.x, lane = tid & 63, w = __builtin_amdgcn_readfirstlane(tid >> 6), q = lane & 31, hi = lane >> 5;
    const int q0 = qb * 256, NT = 4 * (qb + 1);
    bf16x8 qf[DK / 16];
    { const bf16* qrow = Qp + (size_t)(q0 + 32 * w + q) * ldq + 8 * hi;
#pragma unroll
      for (int c = 0; c < DK / 16; ++c) qf[c] = *(const bf16x8*)(qrow + 16 * c); }
    v4u kreg[NKL], vreg[NVL];
#define ATT_LOAD(t) do { \
    _Pragma("unroll") for (int i_ = 0; i_ < NKL; ++i_) { const int id_ = tid + 512 * i_; if ((KCH % 512 == 0) || id_ < KCH) { const int r_ = id_ / KC, c_ = id_ % KC; kreg[i_] = *(const v4u*)(Kp + (size_t)(64 * (t) + r_) * ldk + c_ * 8); } } \
    _Pragma("unroll") for (int i_ = 0; i_ < NVL; ++i_) { const int id_ = tid + 512 * i_; const int d_ = id_ >> 3, c_ = id_ & 7; vreg[i_] = *(const v4u*)(VTp + (size_t)d_ * SEQ + 64 * (t) + c_ * 8); } } while (0)
#define ATT_STORE(buf) do { \
    _Pragma("unroll") for (int i_ = 0; i_ < NKL; ++i_) { const int id_ = tid + 512 * i_; if ((KCH % 512 == 0) || id_ < KCH) { const int r_ = id_ / KC, c_ = id_ % KC; *(LAS v4u*)(lds + (buf) * BUF + r_ * KP + c_ * 16) = kreg[i_]; } } \
    _Pragma("unroll") for (int i_ = 0; i_ < NVL; ++i_) { const int id_ = tid + 512 * i_; const int d_ = id_ >> 3, c_ = id_ & 7; *(LAS v4u*)(lds + (buf) * BUF + KTB + d_ * VP + c_ * 16) = vreg[i_]; } } while (0)
    ATT_LOAD(0); ATT_STORE(0);
    __syncthreads();
    float mrun = -1e30f, lrun = 0.f;
    f32x16 o[NDB];
#pragma unroll
    for (int db = 0; db < NDB; ++db)
#pragma unroll
        for (int r = 0; r < 16; ++r) o[db][r] = 0.f;
    for (int t = 0; t < NT; ++t) {
        const int buf = t & 1;
        if (t + 1 < NT) ATT_LOAD(t + 1);
        const int tb = t - (NT - 4);
        if (tb < 0 || 64 * tb <= 32 * w + 31) {
            const LAS unsigned char* kb_ = lds + buf * BUF + q * KP + hi * 16;
            f32x16 s0, s1;
#pragma unroll
            for (int r = 0; r < 16; ++r) { s0[r] = 0.f; s1[r] = 0.f; }
#pragma unroll
            for (int c = 0; c < DK / 16; ++c) {
                const bf16x8 a0 = *(const LAS bf16x8*)(kb_ + c * 32), a1 = *(const LAS bf16x8*)(kb_ + 32 * KP + c * 32);
                s0 = __builtin_amdgcn_mfma_f32_32x32x16_bf16(a0, qf[c], s0, 0, 0, 0);
                s1 = __builtin_amdgcn_mfma_f32_32x32x16_bf16(a1, qf[c], s1, 0, 0, 0);
            }
            if (tb >= 0) {
                const int qrel = 32 * w + q, kb0 = 64 * tb + 4 * hi;
#pragma unroll
                for (int r = 0; r < 16; ++r) { const int kv = kb0 + (r & 3) + 8 * (r >> 2); if (kv > qrel) s0[r] = -INFINITY; if (kv + 32 > qrel) s1[r] = -INFINITY; }
            }
            float mx = fmaxf(s0[0], s1[0]);
#pragma unroll
            for (int r = 1; r < 16; ++r) mx = fmaxf(mx, fmaxf(s0[r], s1[r]));
            mx = fmaxf(mx, __shfl_xor(mx, 32));
            const float mn = fmaxf(mrun, mx), alpha = __builtin_amdgcn_exp2f(mrun - mn); mrun = mn;
            float ps = 0.f;
#pragma unroll
            for (int r = 0; r < 16; ++r) { s0[r] = __builtin_amdgcn_exp2f(s0[r] - mn); s1[r] = __builtin_amdgcn_exp2f(s1[r] - mn); ps += s0[r] + s1[r]; }
            lrun = lrun * alpha + ps;
#pragma unroll
            for (int db = 0; db < NDB; ++db)
#pragma unroll
                for (int r = 0; r < 16; ++r) o[db][r] *= alpha;
            const LAS unsigned char* vb_ = lds + buf * BUF + KTB + q * VP + hi * 16;
#pragma unroll
            for (int c4 = 0; c4 < 4; ++c4) {
                v4u pw; const int b8 = 8 * (c4 & 1);
                if (c4 < 2) { pw.x = cvt_pk_bf16(s0[b8 + 0], s0[b8 + 1]); pw.y = cvt_pk_bf16(s0[b8 + 2], s0[b8 + 3]); pw.z = cvt_pk_bf16(s0[b8 + 4], s0[b8 + 5]); pw.w = cvt_pk_bf16(s0[b8 + 6], s0[b8 + 7]); }
                else        { pw.x = cvt_pk_bf16(s1[b8 + 0], s1[b8 + 1]); pw.y = cvt_pk_bf16(s1[b8 + 2], s1[b8 + 3]); pw.z = cvt_pk_bf16(s1[b8 + 4], s1[b8 + 5]); pw.w = cvt_pk_bf16(s1[b8 + 6], s1[b8 + 7]); }
                const bf16x8 pb = __builtin_bit_cast(bf16x8, pw);
#pragma unroll
                for (int db = 0; db < NDB; ++db) {
                    const bf16x8 va = *(const LAS bf16x8*)(vb_ + db * 32 * VP + c4 * 32);
                    o[db] = __builtin_amdgcn_mfma_f32_32x32x16_bf16(va, pb, o[db], 0, 0, 0);
                }
            }
        }
        if (t + 1 < NT) ATT_STORE(buf ^ 1);
        __syncthreads();
    }
#undef ATT_LOAD
#undef ATT_STORE
    lrun += __shfl_xor(lrun, 32);
    const float inv = 1.f / lrun;
    bf16* orow = Op + (size_t)(q0 + 32 * w + q) * ldo + 4 * hi;
#pragma unroll
    for (int db = 0; db < NDB; ++db)
#pragma unroll
        for (int g = 0; g < 4; ++g) {
            const f32x4 v = {o[db][4 * g] * inv, o[db][4 * g + 1] * inv, o[db][4 * g + 2] * inv, o[db][4 * g + 3] * inv};
            *(v2u*)(orow + 32 * db + 8 * g) = pack4(v);
        }
}

__device__ __forceinline__ void tr_item(const float* W, int Nsrc, int src0, const float* g, bf16* WT, int Kdim, int dst_row0, int k0, LAS float* scr, int lane) {
#pragma unroll 8
    for (int i = 0; i < 32; ++i) { const int kk = 2 * i + (lane >> 5); float v = 0.f; if (src0 >= 0) { v = W[(size_t)(k0 + kk) * Nsrc + src0 + (lane & 31)]; if (g) v *= g[k0 + kk]; } scr[kk * 33 + (lane & 31)] = v; }
    LDS_WAIT(); asm volatile("" ::: "memory");
    const int c = lane & 7;
#pragma unroll
    for (int j = 0; j < 4; ++j) { const int n = (lane >> 3) + 8 * j; const LAS float* s = scr + (8 * c) * 33 + n;
        v4u o; o.x = pk2(s[0 * 33], s[1 * 33]); o.y = pk2(s[2 * 33], s[3 * 33]); o.z = pk2(s[4 * 33], s[5 * 33]); o.w = pk2(s[6 * 33], s[7 * 33]);
        *(v4u*)(WT + (size_t)(dst_row0 + n) * Kdim + k0 + 8 * c) = o; }
    LDS_WAIT(); asm volatile("" ::: "memory");
}
__device__ __forceinline__ int inproj_src(int pc) {
    if (pc < 512) return 672 + pc;
    if (pc < 1024) return 1184 + (pc - 512);
    if (pc < 1536) return 1696 + (pc - 1024);
    if (pc < 3584) return 2208 + (pc - 1536);
    if (pc < 3968) return pc - 3584;
    if (pc < 4224) return 384 + (pc - 3968);
    if (pc < 4256) return 640 + (pc - 4224);
    return -1;
}

__device__ __forceinline__ void grid_barrier(unsigned* ctr, unsigned target) {
    asm volatile("s_waitcnt vmcnt(0) lgkmcnt(0)" ::: "memory");
    __syncthreads();
    if (threadIdx.x == 0) {
        __builtin_amdgcn_fence(__ATOMIC_RELEASE, "agent");
        asm volatile("s_waitcnt vmcnt(0)" ::: "memory");
        __hip_atomic_fetch_add(ctr, 1u, __ATOMIC_RELAXED, __HIP_MEMORY_SCOPE_AGENT);
        unsigned spins = 0;
        while (__hip_atomic_load(ctr, __ATOMIC_RELAXED, __HIP_MEMORY_SCOPE_AGENT) < target) { __builtin_amdgcn_s_sleep(2); if (++spins > (1u << 24)) break; }
    }
    __syncthreads();
    __builtin_amdgcn_fence(__ATOMIC_ACQUIRE, "agent");
    asm volatile("s_waitcnt vmcnt(0)" ::: "memory");
    __syncthreads();
}
#define GRID_SYNC() do { ++bar_k; grid_barrier(bar_ctr, bar_k * (unsigned)G); } while (0)
struct Args {
    const float* x; const int* positions; const float *norm_mix_g, *w_in, *b_gate, *mla_q_norm_g, *mla_w_uq, *mla_kv_norm_g, *mla_w_ukv;
    const float *lq1, *lk1, *lq2, *lk2, *subln_g, *w_branch_mla, *w_branch_diff, *w_out, *norm_ffn_g, *w_ffn_gate, *w_ffn_up, *w_ffn_down, *norm_final_g;
    float* out; unsigned char* ws;
};

__global__ void __launch_bounds__(512, 2) fwd_megakernel(Args a) {
    extern __shared__ __attribute__((aligned(16))) unsigned char lds_raw[];
    LAS unsigned char* lds = (LAS unsigned char*)lds_raw;
    cg::grid_group grid = cg::this_grid();
    const int tid = threadIdx.x, lane = tid & 63, wave = __builtin_amdgcn_readfirstlane(tid >> 6);
    const int G = gridDim.x, bx = blockIdx.x;
    const int vcu = (G % 8 == 0) ? (bx % 8) * (G / 8) + bx / 8 : bx;
    const int gw = vcu * 8 + wave, NGW = G * 8;
    unsigned char* ws = a.ws;
    unsigned* bar_ctr = (unsigned*)(ws + WS_SS); unsigned bar_k = 0;
    float* ssq = (float*)(ws + WS_PART); float* sskv = ssq + (size_t)M * 16; float* ss1 = sskv + (size_t)M * 16; float* ss2 = ss1 + (size_t)M * 16;
    float* tdc = (float*)(ws + WS_TAB); float* tds = tdc + (size_t)M * 8; float* tmc = tds + (size_t)M * 8; float* tms = tmc + (size_t)M * 16;
    bf16 *W1 = (bf16*)(ws + WS_W1), *W2A = (bf16*)(ws + WS_W2A), *W2B = (bf16*)(ws + WS_W2B), *W3A = (bf16*)(ws + WS_W3A), *W3B = (bf16*)(ws + WS_W3B), *W4 = (bf16*)(ws + WS_W4), *W5 = (bf16*)(ws + WS_W5), *W6 = (bf16*)(ws + WS_W6);
    bf16 *XN = (bf16*)(ws + WS_XN), *QL = (bf16*)(ws + WS_QL), *KVL = (bf16*)(ws + WS_KVL), *OM = (bf16*)(ws + WS_OM), *ODR = (bf16*)(ws + WS_ODR);
    bf16 *QD = (bf16*)(ws + WS_QD), *ODN = (bf16*)(ws + WS_ODN), *KD = (bf16*)(ws + WS_KD), *VDT = (bf16*)(ws + WS_VDT), *MERGED = (bf16*)(ws + WS_MERGED);
    bf16 *QM = (bf16*)(ws + WS_QM), *KM = (bf16*)(ws + WS_KM), *VMT = (bf16*)(ws + WS_VMT), *X1B = (bf16*)(ws + WS_X1B), *HB = (bf16*)(ws + WS_H);
    float* TMP = (float*)(ws + WS_TMP);
    bf16* GATES = (bf16*)a.out;

    if (PH(0)) {
        LAS float* scr = (LAS float*)(lds + wave * 16384);
        constexpr int I1 = 16 * (N1 / 32), I2A = 6 * 24, I2B = 4 * 32, I3 = 8 * 32, I4 = 16 * 32, I5 = 16 * (2 * FF / 32), I6 = (FF / 64) * 32;
        constexpr int NITEMS = I1 + I2A + I2B + 2 * I3 + I4 + I5 + I6;
        for (int it = gw; it < NITEMS; it += NGW) {
            int r = it;
            if (r < I1) { const int nb = r % (N1 / 32), kb = r / (N1 / 32); tr_item(a.w_in, 4256, inproj_src(32 * nb), nullptr, W1, 1024, 32 * nb, 64 * kb, scr, lane); continue; } r -= I1;
            if (r < I2A) { const int nb = r % 24, kb = r / 24; tr_item(a.mla_w_uq, 768, 32 * nb, a.mla_q_norm_g, W2A, 384, 32 * nb, 64 * kb, scr, lane); continue; } r -= I2A;
            if (r < I2B) { const int nb = r % 32, kb = r / 32; tr_item(a.mla_w_ukv, 1024, 32 * nb, a.mla_kv_norm_g, W2B, 256, 32 * nb, 64 * kb, scr, lane); continue; } r -= I2B;
            if (r < I3) { const int nb = r % 32, kb = r / 32; tr_item(a.w_branch_mla, 1024, 32 * nb, nullptr, W3A, 512, 32 * nb, 64 * kb, scr, lane); continue; } r -= I3;
            if (r < I3) { const int nb = r % 32, kb = r / 32; tr_item(a.w_branch_diff, 1024, 32 * nb, nullptr, W3B, 512, 32 * nb, 64 * kb, scr, lane); continue; } r -= I3;
            if (r < I4) { const int nb = r % 32, kb = r / 32; tr_item(a.w_out, 1024, 32 * nb, nullptr, W4, 1024, 32 * nb, 64 * kb, scr, lane); continue; } r -= I4;
            if (r < I5) { const int nb = r % (2 * FF / 32), kb = r / (2 * FF / 32); const int pc = 32 * nb, tile = pc >> 8, inner = pc & 255;
                const float* W = inner < 128 ? a.w_ffn_gate : a.w_ffn_up; tr_item(W, FF, 128 * tile + (inner & 127), a.norm_ffn_g, W5, 1024, pc, 64 * kb, scr, lane); continue; } r -= I5;
            { const int nb = r % 32, kb = r / 32; tr_item(a.w_ffn_down, 1024, 32 * nb, nullptr, W6, FF, 32 * nb, 64 * kb, scr, lane); }
        }
        for (int m = gw; m < M; m += NGW) {
            const f32x4* xr = (const f32x4*)(a.x + (size_t)m * D) + lane; const f32x4* gr = (const f32x4*)a.norm_mix_g + lane;
            f32x4 v[4]; float s = 0.f;
#pragma unroll
            for (int j = 0; j < 4; ++j) { v[j] = xr[64 * j]; s += (v[j][0] * v[j][0] + v[j][1] * v[j][1]) + (v[j][2] * v[j][2] + v[j][3] * v[j][3]); }
            const float rs = rsqrtf(wave_sum(s) * (1.f / D) + EPS);
            v2u* o8 = (v2u*)(XN + (size_t)m * D) + lane;
#pragma unroll
            for (int j = 0; j < 4; ++j) o8[64 * j] = pack4(v[j] * rs * gr[64 * j]);
        }
        const int gt = vcu * 512 + tid, NGT = G * 512;
        for (int i = gt; i < M * 24; i += NGT) {
            const int tok = i / 24, f = i % 24; const float pos = (float)a.positions[tok];
            const bool dm = f >= 8; const int fi = dm ? f - 8 : f;
            const float inv = expf((-13.122363377404328f * (float)fi) * (dm ? (2.0f / 32.0f) : (2.0f / 16.0f)));
            const float ang = pos * inv;
            const double ad = (double)ang, kd = rint(ad * 0.15915494309189535), rd = ad - kd * 6.283185307179586;
            const float rr = (float)rd, cs = __cosf(rr), sn = __sinf(rr);
            if (dm) { tmc[(size_t)tok * 16 + fi] = cs; tms[(size_t)tok * 16 + fi] = sn; } else { tdc[(size_t)tok * 8 + fi] = cs; tds[(size_t)tok * 8 + fi] = sn; }
        }
    }
    GRID_SYNC();
    grid.sync();

    if (PH(1)) {
        pg8::Gemm g{XN, W1, M, N1, D}; pg8::StaticOrder S; S.init(M, N1, G, bx);
        EpiInProj E{QD, KD, VDT, GATES, QL, KVL, KM, a.b_gate, tdc, tds, tmc, tms, ssq, sskv};
        pg8::gemm_phase<EpiInProj, pg8::StaticOrder, true, true>(lds, g, S, E);
    }
    GRID_SYNC();

    if (PH(2)) {
        pg8::Gemm g{KVL, W2B, M, 1024, 256}; pg8::StaticOrder S; S.init(M, 1024, G, bx);
        EpiKVup E{KM, VMT, sskv};
        pg8::gemm_phase<EpiKVup, pg8::StaticOrder, true, true>(lds, g, S, E);
    }
    __syncthreads();
    if (PH(3)) {
        pg8::Gemm g{QL, W2A, M, 768, 384}; pg8::StaticOrder S; S.init(M, 768, G, bx);
        EpiQup E{QM, ssq, tmc, tms};
        pg8::gemm_phase<EpiQup, pg8::StaticOrder, true, true>(lds, g, S, E);
    }
    GRID_SYNC();

    if (PH(4)) for (int j = vcu; j < 1024; j += G) {
        const int i = j >> 8, v = j & 255, bh = v >> 4, s = v & 15;
        if (i < 2) {
            const int b = bh >> 3, h = bh & 7, qb = (i == 0) ? s : 31 - s;
            attn_unit<96, 64>(lds, QM + (size_t)b * SEQ * 768 + h * 96, 768, KM + (size_t)b * SEQ * 768 + h * 96, 768, VMT + (size_t)(b * 8 + h) * 64 * SEQ, OM + (size_t)b * SEQ * 512 + h * 64, 512, qb);
        } else {
            const int b = bh >> 3, h = (bh >> 1) & 3, c = bh & 1, qb = (i == 2) ? 15 - s : 16 + s;
            attn_unit<64, 128>(lds, QD + (size_t)b * SEQ * 512 + (h * 2 + c) * 64, 512, KD + (size_t)b * SEQ * 512 + (h * 2 + c) * 64, 512, VDT + (size_t)(b * 4 + h) * 128 * SEQ, ODR + (size_t)b * SEQ * 1024 + (h * 2 + c) * 128, 1024, qb);
        }
    }
    GRID_SYNC();

    if (PH(5)) {
        pg8::Gemm g{OM, W3A, M, D, 512}; pg8::StaticOrder S; S.init(M, D, G, bx);
        EpiBranch<0> E{GATES, TMP, MERGED};
        pg8::gemm_phase<EpiBranch<0>, pg8::StaticOrder, true, true>(lds, g, S, E);
    }
    if (PH(6)) {
        const float d1 = wave_sum(a.lq1[lane] * a.lk1[lane]), d2 = wave_sum(a.lq2[lane] * a.lk2[lane]);
        const float lam = expf(d1) - expf(d2) + LAMBDA_INIT;
        f32x4 g0 = *(const f32x4*)(a.subln_g + 8 * (lane & 15)), g1 = *(const f32x4*)(a.subln_g + 8 * (lane & 15) + 4);
        g0 = g0 * (1.f - LAMBDA_INIT); g1 = g1 * (1.f - LAMBDA_INIT);
        for (int m = gw; m < M; m += NGW) {
            const int h = lane >> 4, dd = 8 * (lane & 15);
            const v4u w1 = *(const v4u*)(ODR + (size_t)m * 1024 + h * 256 + dd), w2 = *(const v4u*)(ODR + (size_t)m * 1024 + h * 256 + 128 + dd);
            float v[8];
#pragma unroll
            for (int k = 0; k < 4; ++k) { v[2 * k] = bf2f(w1[k] & 0xffffu) - lam * bf2f(w2[k] & 0xffffu); v[2 * k + 1] = bf2f(w1[k] >> 16) - lam * bf2f(w2[k] >> 16); }
            float s = 0.f;
#pragma unroll
            for (int k = 0; k < 8; ++k) s += v[k] * v[k];
            s += __shfl_xor(s, 1); s += __shfl_xor(s, 2); s += __shfl_xor(s, 4); s += __shfl_xor(s, 8);
            const float rs = rsqrtf(s * (1.f / 128.f) + EPS);
            const f32x4 o0 = {v[0] * rs * g0[0], v[1] * rs * g0[1], v[2] * rs * g0[2], v[3] * rs * g0[3]}, o1 = {v[4] * rs * g1[0], v[5] * rs * g1[1], v[6] * rs * g1[2], v[7] * rs * g1[3]};
            *(v4u*)(ODN + (size_t)m * 512 + h * 128 + dd) = pack8(o0, o1);
        }
    }
    GRID_SYNC();

    if (PH(7)) {
        pg8::Gemm g{ODN, W3B, M, D, 512}; pg8::StaticOrder S; S.init(M, D, G, bx);
        EpiBranch<1> E{GATES, TMP, MERGED};
        pg8::gemm_phase<EpiBranch<1>, pg8::StaticOrder, true, true>(lds, g, S, E);
    }
    GRID_SYNC();

    if (PH(8)) {
        pg8::Gemm g{MERGED, W4, M, D, D}; pg8::StaticOrder S; S.init(M, D, G, bx);
        EpiRes E{a.x, a.out, X1B, ss1};
        pg8::gemm_phase<EpiRes, pg8::StaticOrder, true, true>(lds, g, S, E);
    }
    GRID_SYNC();

    if (PH(9)) {
        pg8::Gemm g{X1B, W5, M, 2 * FF, D}; pg8::StaticOrder S; S.init(M, 2 * FF, G, bx);
        EpiSwiglu E{HB, ss1};
        pg8::gemm_phase<EpiSwiglu, pg8::StaticOrder, true, true>(lds, g, S, E);
    }
    GRID_SYNC();

    if (PH(10)) {
        pg8::Gemm g{HB, W6, M, D, FF}; pg8::StaticOrder S; S.init(M, D, G, bx);
        EpiRes E{a.out, a.out, nullptr, ss2};
        pg8::gemm_phase<EpiRes, pg8::StaticOrder, true, true>(lds, g, S, E);
    }
    GRID_SYNC();

    if (PH(11)) for (int m = gw; m < M; m += NGW) {
        f32x4* xr = (f32x4*)(a.out + (size_t)m * D) + lane; const f32x4* gr = (const f32x4*)a.norm_final_g + lane;
        float sq = ss2[(size_t)m * 16 + (lane & 15)];
        sq += __shfl_xor(sq, 1); sq += __shfl_xor(sq, 2); sq += __shfl_xor(sq, 4); sq += __shfl_xor(sq, 8);
        const float rs = rsqrtf(sq * (1.f / D) + EPS);
#pragma unroll
        for (int j = 0; j < 4; ++j) xr[64 * j] = xr[64 * j] * rs * gr[64 * j];
    }
}

extern "C" void kernel_launch(void* const* d_in, const int* in_sizes, int n_in, void* d_out, int out_size, void* d_ws, size_t ws_size, hipStream_t stream) {
    static int grid = 0;
    if (grid == 0) {
        if (n_in != 22 || in_sizes[0] != M * D || out_size != M * D || ws_size < WS_END) { fprintf(stderr, "kernel_launch: unexpected shapes (n_in %d, ws %zu)\n", n_in, ws_size); grid = -1; return; }
        int dev = 0, cus = 0, per_cu = 0;
        hipGetDevice(&dev); hipDeviceGetAttribute(&cus, hipDeviceAttributeMultiprocessorCount, dev);
        hipFuncSetAttribute((const void*)fwd_megakernel, hipFuncAttributeMaxDynamicSharedMemorySize, LDS_BYTES);
        hipOccupancyMaxActiveBlocksPerMultiprocessor(&per_cu, (const void*)fwd_megakernel, 512, LDS_BYTES);
        if (per_cu < 1) { fprintf(stderr, "kernel_launch: occupancy query says %d blocks per CU\n", per_cu); per_cu = 1; }
        grid = cus * (per_cu > 1 ? 1 : per_cu);
        (void)hipGetLastError();
    }
    if (grid < 0) return;
    if (hipMemsetAsync(d_ws, 0, 256, stream) != hipSuccess) { fprintf(stderr, "kernel_launch: memset failed\n"); return; }
    Args a{};
    a.x = (const float*)d_in[0]; a.positions = (const int*)d_in[1]; a.norm_mix_g = (const float*)d_in[2]; a.w_in = (const float*)d_in[3]; a.b_gate = (const float*)d_in[4];
    a.mla_q_norm_g = (const float*)d_in[5]; a.mla_w_uq = (const float*)d_in[6]; a.mla_kv_norm_g = (const float*)d_in[7]; a.mla_w_ukv = (const float*)d_in[8];
    a.lq1 = (const float*)d_in[9]; a.lk1 = (const float*)d_in[10]; a.lq2 = (const float*)d_in[11]; a.lk2 = (const float*)d_in[12]; a.subln_g = (const float*)d_in[13];
    a.w_branch_mla = (const float*)d_in[14]; a.w_branch_diff = (const float*)d_in[15]; a.w_out = (const float*)d_in[16]; a.norm_ffn_g = (const float*)d_in[17];
    a.w_ffn_gate = (const float*)d_in[18]; a.w_ffn_up = (const float*)d_in[19]; a.w_ffn_down = (const float*)d_in[20]; a.norm_final_g = (const float*)d_in[21];
    a.out = (float*)d_out; a.ws = (unsigned char*)d_ws;
    void* args[] = {&a};
    hipError_t e = hipLaunchCooperativeKernel((const void*)fwd_megakernel, dim3(grid), dim3(512), args, LDS_BYTES, stream);
    if (e != hipSuccess) fprintf(stderr, "cooperative launch failed: %s (grid %d)\n", hipGetErrorString(e), grid);
}
```

```cpp
#include <hip/hip_runtime.h>
#include <hip/hip_cooperative_groups.h>
#include <cstdio>
#include <cstdint>
namespace cg = cooperative_groups;
namespace pg8 {
#define PG8_LAS __attribute__((address_space(3)))
typedef unsigned short bf16_t;
typedef short bf16x8 __attribute__((ext_vector_type(8)));
typedef float f32x4 __attribute__((ext_vector_type(4)));
typedef unsigned u32x4 __attribute__((ext_vector_type(4)));
constexpr int BM = 256, BK = 64, HALF = 128, HTB = HALF * BK * 2  , STAGE_BYTES = 8 * HTB, NXCD = 8, WGM = 8;

__host__ __device__ __forceinline__ int lds_byte(int r, int c) { const int st = (r >> 4) * 2 + (c >> 5), rr = r & 15, cc = c & 31, ob = rr * 64 + cc * 2; return st * 1024 + (ob ^ (((ob >> 9) & 1) << 5)); }
__host__ __device__ __forceinline__ void stage_rc(int b, int& R, int& C) { const int st = b / 1024, sb = b % 1024, swz = sb ^ (((sb >> 9) & 1) << 5); R = (st >> 1) * 16 + swz / 64; C = (st & 1) * 32 + (swz % 64) / 2; }
__host__ __device__ __forceinline__ int perm32(int rho) { const int n = rho >> 4, i = rho & 15; return 8 * (i >> 2) + 4 * n + (i & 3); }

struct Unit { int pm, pn; };
struct Gemm { const bf16_t* A; const bf16_t* Bt; int M, N, K; };

struct StaticOrder {
    int nM, nN, nwg, G, c;
    __host__ __device__ void init(int M, int N, int G_, int c_) { nM = M / BM; nN = N / BM; nwg = nM * nN; G = G_; c = c_; }
    __host__ __device__ bool next(int i, Unit& u) const {
        const long L = (long)i * G + c; if (L >= nwg) return false;
        int wgid = (int)L; { const int q = nwg / NXCD, r = nwg % NXCD, xcd = wgid % NXCD, off = wgid / NXCD; wgid = (xcd < r ? xcd * (q + 1) : r * (q + 1) + (xcd - r) * q) + off; }
        const int nig = WGM * nN, gid = wgid / nig, fm = gid * WGM, gsz = (nM - fm) < WGM ? (nM - fm) : WGM;
        u.pm = fm + ((wgid % nig) % gsz); u.pn = (wgid % nig) / gsz; return true;
    }
    __device__ __forceinline__ void a_ready(const Unit&) const {}
    __device__ __forceinline__ void done(const Unit&) const {}
};

typedef float f32x2_t __attribute__((ext_vector_type(2))); typedef __bf16 bf16x2_t __attribute__((ext_vector_type(2)));
__device__ __forceinline__ unsigned cvt_pk_bf16(float lo, float hi) { f32x2_t v = {lo, hi}; bf16x2_t b = __builtin_convertvector(v, bf16x2_t); return __builtin_bit_cast(unsigned, b); }
typedef float f32x2 __attribute__((ext_vector_type(2)));
template <class Epi, class Sched, bool ALIGN_EPI = false, bool SP2 = false>
__device__ __forceinline__ void gemm_phase(PG8_LAS unsigned char* lds, const Gemm g, const Sched& S, const Epi& E) {
    const int tid = threadIdx.x, wid = __builtin_amdgcn_readfirstlane(tid >> 6), lane = tid & 63, wr = wid >> 2, wc = wid & 3, fr = lane & 15, fq = lane >> 4;
    const int K = g.K, nt = K / BK;
    unsigned voffA[2], voffB[2];
#pragma unroll
    for (int i = 0; i < 2; ++i) { int R, C; stage_rc(tid * 16 + i * 8192, R, C); const int Rb = Epi::PERM ? ((R & ~31) + perm32(R & 31)) : R;
        voffA[i] = (unsigned)(R * K + C) * 2u; voffB[i] = (unsigned)(Rb * K + C) * 2u; }
    const size_t kstep = (size_t)(BK * 2);
    const size_t hstep = (size_t)HALF * K * 2;
    const size_t tstep = 2 * hstep;
    const unsigned ldsw = (unsigned)wid * 1024u;
    const int aoff = lds_byte(wr * 64 + fr, fq * 8), boff = lds_byte(wc * 32 + fr, fq * 8);
#define PG8_SA(b, h) (((b) * 2 + (h)) * HTB)
#define PG8_SB(b, h) ((4 + (b) * 2 + (h)) * HTB)
#define PG8_STAGE(bufoff, gbase, voff) do { _Pragma("unroll") for (int _i = 0; _i < 2; ++_i) \
        __builtin_amdgcn_global_load_lds((const unsigned*)((const char*)(gbase) + (voff)[_i]), (PG8_LAS unsigned*)(lds + (bufoff) + ldsw + _i * 8192), 16, 0, 0); } while (0)
#define PG8_LDA(dst, b, h) do { _Pragma("unroll") for (int m = 0; m < 4; ++m) _Pragma("unroll") for (int k = 0; k < 2; ++k) dst[m][k] = *(const PG8_LAS bf16x8*)(lds + PG8_SA(b, h) + aoff + m * 2048 + k * 1024); } while (0)
#define PG8_LDB(dst, b, h) do { _Pragma("unroll") for (int n = 0; n < 2; ++n) _Pragma("unroll") for (int k = 0; k < 2; ++k) dst[n][k] = *(const PG8_LAS bf16x8*)(lds + PG8_SB(b, h) + boff + n * 2048 + k * 1024); } while (0)
#define PG8_MMA(ai, bj, At, Bt) do { __builtin_amdgcn_s_setprio(1); _Pragma("unroll") for (int m = 0; m < 4; ++m) _Pragma("unroll") for (int n = 0; n < 2; ++n) _Pragma("unroll") for (int k = 0; k < 2; ++k) \
        acc[ai][bj][m][n] = __builtin_amdgcn_mfma_f32_16x16x32_bf16(Bt[n][k], At[m][k], acc[ai][bj][m][n], 0, 0, 0); __builtin_amdgcn_s_setprio(0); } while (0)
#define PG8_WAIT_V(n) asm volatile("s_waitcnt vmcnt(" #n ")" ::: "memory")
#define PG8_WAIT_L(n) asm volatile("s_waitcnt lgkmcnt(" #n ")" ::: "memory")
#define PG8_BAR __builtin_amdgcn_s_barrier()
#define PG8_SCHED __builtin_amdgcn_sched_barrier(0)
    Unit cur, nxt; int ui = 0;
    if (!S.next(0, cur)) return;
    f32x4 acc[2][2][4][2];
#pragma unroll
    for (int a = 0; a < 2; ++a)
#pragma unroll
        for (int b = 0; b < 2; ++b)
#pragma unroll
            for (int m = 0; m < 4; ++m)
#pragma unroll
                for (int n = 0; n < 2; ++n) acc[a][b][m][n] = (f32x4){0.f, 0.f, 0.f, 0.f};
    bf16x8 At[4][2], B0[2][2], B1[2][2];
    const char* cA = (const char*)g.A + (size_t)cur.pm * tstep; const char* cB = (const char*)g.Bt + (size_t)cur.pn * tstep;
    S.a_ready(cur);
    if constexpr (SP2) {
        PG8_STAGE(PG8_SB(0, 0), cB, voffB); PG8_STAGE(PG8_SB(0, 1), cB + hstep, voffB); PG8_STAGE(PG8_SA(0, 0), cA, voffA); PG8_STAGE(PG8_SA(0, 1), cA + hstep, voffA);
        if (wr == 1) PG8_BAR;
        PG8_WAIT_V(2); PG8_BAR;
        PG8_STAGE(PG8_SB(1, 0), cB + kstep, voffB); PG8_STAGE(PG8_SA(1, 0), cA + kstep, voffA); PG8_STAGE(PG8_SB(1, 1), cB + hstep + kstep, voffB);
        PG8_WAIT_V(6); PG8_BAR;
    } else {
        PG8_STAGE(PG8_SB(0, 0), cB, voffB); PG8_STAGE(PG8_SA(0, 0), cA, voffA); PG8_STAGE(PG8_SB(0, 1), cB + hstep, voffB); PG8_STAGE(PG8_SA(0, 1), cA + hstep, voffA);
        if (wr == 1) PG8_BAR;
        PG8_WAIT_V(4); PG8_BAR;
        PG8_STAGE(PG8_SB(1, 0), cB + kstep, voffB); PG8_STAGE(PG8_SA(1, 0), cA + kstep, voffA); PG8_STAGE(PG8_SB(1, 1), cB + hstep + kstep, voffB);
        PG8_WAIT_V(6); PG8_BAR;
    }
    for (;;) {
        const bool has_next = S.next(ui + 1, nxt);
        const char* nA = has_next ? (const char*)g.A + (size_t)nxt.pm * tstep : cA; const char* nB = has_next ? (const char*)g.Bt + (size_t)nxt.pn * tstep : cB;
#pragma unroll 1
        for (int t = 0; t < nt; t += 2) {
            const bool last = (t == nt - 2);
            const char* a1 = cA + (size_t)(t + 1) * kstep;
            const char* a2 = last ? nA : cA + (size_t)(t + 2) * kstep; const char* b2 = last ? nB : cB + (size_t)(t + 2) * kstep;
            const char* a3 = a2 + kstep; const char* b3 = b2 + kstep;
            if (last && has_next) S.a_ready(nxt);
            if constexpr (SP2) {
            PG8_LDB(B0, 0, 0); PG8_LDB(B1, 0, 1); PG8_SCHED; PG8_LDA(At, 0, 0); PG8_STAGE(PG8_SA(1, 1), a1 + hstep, voffA);
            PG8_WAIT_V(8); PG8_WAIT_L(0); PG8_BAR; PG8_MMA(0, 0, At, B0); PG8_MMA(0, 1, At, B1); PG8_BAR; PG8_SCHED;
            PG8_LDA(At, 0, 1); PG8_STAGE(PG8_SB(0, 0), b2, voffB); PG8_STAGE(PG8_SB(0, 1), b2 + hstep, voffB); PG8_STAGE(PG8_SA(0, 0), a2, voffA);
            PG8_WAIT_V(8); PG8_WAIT_L(0); PG8_BAR; PG8_MMA(1, 0, At, B0); PG8_MMA(1, 1, At, B1); PG8_BAR; PG8_SCHED;
            PG8_LDB(B0, 1, 0); PG8_LDB(B1, 1, 1); PG8_SCHED; PG8_LDA(At, 1, 0); PG8_STAGE(PG8_SA(0, 1), a2 + hstep, voffA);
            PG8_WAIT_V(8); PG8_WAIT_L(0); PG8_BAR; PG8_MMA(0, 0, At, B0); PG8_MMA(0, 1, At, B1); PG8_BAR; PG8_SCHED;
            PG8_LDA(At, 1, 1); PG8_STAGE(PG8_SB(1, 0), b3, voffB); PG8_STAGE(PG8_SB(1, 1), b3 + hstep, voffB); PG8_STAGE(PG8_SA(1, 0), a3, voffA);
            PG8_WAIT_V(8); PG8_WAIT_L(0); PG8_BAR; PG8_MMA(1, 0, At, B0); PG8_MMA(1, 1, At, B1); PG8_BAR; PG8_SCHED;
            } else {
            PG8_LDB(B0, 0, 0); PG8_SCHED; PG8_LDA(At, 0, 0); PG8_STAGE(PG8_SA(1, 1), a1 + hstep, voffA);
            PG8_WAIT_L(8); PG8_BAR; PG8_WAIT_L(0); PG8_MMA(0, 0, At, B0); PG8_BAR; PG8_SCHED;
            PG8_LDB(B1, 0, 1); PG8_STAGE(PG8_SB(0, 0), b2, voffB);
            PG8_BAR; PG8_WAIT_L(0); PG8_MMA(0, 1, At, B1); PG8_BAR;
            PG8_LDA(At, 0, 1); PG8_STAGE(PG8_SA(0, 0), a2, voffA);
            PG8_BAR; PG8_WAIT_L(0); PG8_MMA(1, 0, At, B0); PG8_BAR; PG8_SCHED;
            PG8_STAGE(PG8_SB(0, 1), b2 + hstep, voffB);
            PG8_WAIT_V(6); PG8_BAR; PG8_MMA(1, 1, At, B1); PG8_BAR;
            PG8_LDB(B0, 1, 0); PG8_SCHED; PG8_LDA(At, 1, 0); PG8_STAGE(PG8_SA(0, 1), a2 + hstep, voffA);
            PG8_WAIT_L(8); PG8_BAR; PG8_WAIT_L(0); PG8_MMA(0, 0, At, B0); PG8_BAR; PG8_SCHED;
            PG8_LDB(B1, 1, 1); PG8_STAGE(PG8_SB(1, 0), b3, voffB);
            PG8_BAR; PG8_WAIT_L(0); PG8_MMA(0, 1, At, B1); PG8_BAR;
            PG8_LDA(At, 1, 1); PG8_STAGE(PG8_SA(1, 0), a3, voffA);
            PG8_BAR; PG8_WAIT_L(0); PG8_MMA(1, 0, At, B0); PG8_BAR; PG8_SCHED;
            PG8_STAGE(PG8_SB(1, 1), b3 + hstep, voffB);
            PG8_WAIT_V(6); PG8_BAR; PG8_MMA(1, 1, At, B1); PG8_BAR;
            }
        }
        if constexpr (ALIGN_EPI) { if (wr == 0) PG8_BAR; }
        if constexpr (!Epi::AFTER_DRAIN) { E(acc, cur, wr, wc, fr, fq); S.done(cur); }
        if (!has_next) break;
#pragma unroll
        for (int a = 0; a < 2; ++a)
#pragma unroll
            for (int b = 0; b < 2; ++b)
#pragma unroll
                for (int m = 0; m < 4; ++m)
#pragma unroll
                    for (int n = 0; n < 2; ++n) acc[a][b][m][n] = (f32x4){0.f, 0.f, 0.f, 0.f};
        cur = nxt; cA = nA; cB = nB; ++ui;
        if constexpr (ALIGN_EPI) { if (wr == 1) PG8_BAR; }
    }
    PG8_WAIT_V(0);
    if constexpr (!ALIGN_EPI) { if (wr == 0) PG8_BAR; }
    PG8_BAR;
    if constexpr (Epi::AFTER_DRAIN) { E.fused(acc, cur, wr, wc, fr, fq, lds, wid, lane); S.done(cur); }
#undef PG8_SA
#undef PG8_SB
#undef PG8_STAGE
#undef PG8_LDA
#undef PG8_LDB
#undef PG8_MMA
#undef PG8_WAIT_V
#undef PG8_WAIT_L
#undef PG8_BAR
#undef PG8_SCHED
}
}

#ifndef PH_MASK
#define PH_MASK 0xFFFF
#endif
#define PH(k) ((PH_MASK >> (k)) & 1)
constexpr int NB = 2, SEQ = 8192, M = NB * SEQ, D = 1024;
constexpr int N1 = 4352;
constexpr int FF = 2816;
constexpr float EPS = 1e-6f;
constexpr float LOG2E = 1.4426950408889634f;
constexpr float QS_M = 0.10206207261596577f * LOG2E;
constexpr float QS_D = 0.125f * LOG2E;
constexpr float LAMBDA_INIT = 0.2f;

constexpr size_t MiB = 1u << 20;
constexpr size_t WS_SS = 0;
constexpr size_t WS_TAB = 1 * MiB;
constexpr size_t WS_W1 = 4 * MiB, WS_W2A = 13 * MiB, WS_W2B = 14 * MiB, WS_W3A = 15 * MiB, WS_W3B = 16 * MiB, WS_W4 = 17 * MiB, WS_W5 = 19 * MiB, WS_W6 = 30 * MiB;
constexpr size_t WS_XN = 36 * MiB, WS_QL = 68 * MiB, WS_KVL = 80 * MiB;
constexpr size_t WS_OM = 36 * MiB, WS_ODR = 52 * MiB;
constexpr size_t WS_QD = 88 * MiB, WS_ODN = 88 * MiB;
constexpr size_t WS_KD = 104 * MiB, WS_VDT = 120 * MiB, WS_MERGED = 104 * MiB;
constexpr size_t WS_QM = 136 * MiB, WS_KM = 160 * MiB, WS_VMT = 184 * MiB, WS_TMP = 136 * MiB;
constexpr size_t WS_X1B = 200 * MiB;
constexpr size_t WS_H = 36 * MiB;
constexpr size_t WS_PART = 232 * MiB;
constexpr size_t WS_END = 236 * MiB;

constexpr int LDS_BYTES = 147456;

#define LAS __attribute__((address_space(3)))
typedef unsigned short bf16;
typedef unsigned v4u __attribute__((ext_vector_type(4)));
typedef unsigned v2u __attribute__((ext_vector_type(2)));
typedef float f32x4 __attribute__((ext_vector_type(4)));
typedef float f32x16 __attribute__((ext_vector_type(16)));
typedef short bf16x8 __attribute__((ext_vector_type(8)));
using pg8::cvt_pk_bf16;
#define LDS_WAIT() asm volatile("s_waitcnt lgkmcnt(0)" ::: "memory")
__device__ __forceinline__ unsigned f2bf(float f) { unsigned u = __builtin_bit_cast(unsigned, f); return (u + 0x7fffu + ((u >> 16) & 1u)) >> 16; }
__device__ __forceinline__ unsigned pk2(float lo, float hi) { return f2bf(lo) | (f2bf(hi) << 16); }
__device__ __forceinline__ float bf2f(unsigned h) { return __builtin_bit_cast(float, h << 16); }
__device__ __forceinline__ float wave_sum(float v) {
#pragma unroll
    for (int o = 1; o < 64; o <<= 1) v += __shfl_xor(v, o);
    return v;
}
__device__ __forceinline__ int p16(int k) { return ((k >> 2) & 1) * 8 + (k >> 3) * 4 + (k & 3); }
__device__ __forceinline__ float sigmoidf_(float v) { return __builtin_amdgcn_rcpf(1.f + __builtin_amdgcn_exp2f(-v * LOG2E)); }
__device__ __forceinline__ v2u pack4(f32x4 v) { v2u r; r.x = cvt_pk_bf16(v[0], v[1]); r.y = cvt_pk_bf16(v[2], v[3]); return r; }
__device__ __forceinline__ v4u pack8(f32x4 a, f32x4 b) { v4u r; r.x = cvt_pk_bf16(a[0], a[1]); r.y = cvt_pk_bf16(a[2], a[3]); r.z = cvt_pk_bf16(b[0], b[1]); r.w = cvt_pk_bf16(b[2], b[3]); return r; }

using pg8::Unit;
struct EpiInProj {
    static constexpr bool PERM = true, AFTER_DRAIN = false;
    bf16 *Qd, *Kd, *VdT, *GATES, *QL, *KVL, *Km; const float *bgate, *tdc, *tds, *tmc, *tms; float *ssq, *sskv;
    __device__ __forceinline__ void operator()(const f32x4 (&acc)[2][2][4][2], const Unit& u, int wr, int wc, int fr, int fq) const {
        const int pn = u.pn; const int row0 = u.pm * 256 + wr * 64 + fr;
        if (pn < 4) {
            bf16* dst = pn < 2 ? Qd : Kd; const float sc = pn < 2 ? QS_D : 1.f; const int cb = (pn & 1) * 256 + wc * 32 + 8 * fq;
            const bool rope = (wc & 1) == 0;
#pragma unroll
            for (int ai = 0; ai < 2; ++ai)
#pragma unroll
                for (int m = 0; m < 4; ++m) {
                    const int row = row0 + ai * 128 + m * 16;
                    f32x4 c0 = {1.f, 1.f, 1.f, 1.f}, c1 = c0, s0 = {0.f, 0.f, 0.f, 0.f}, s1 = s0;
                    if (rope) { c0 = *(const f32x4*)(tdc + (size_t)row * 8); c1 = *(const f32x4*)(tdc + (size_t)row * 8 + 4); s0 = *(const f32x4*)(tds + (size_t)row * 8); s1 = *(const f32x4*)(tds + (size_t)row * 8 + 4); }
#pragma unroll
                    for (int bj = 0; bj < 2; ++bj) {
                        f32x4 v0 = acc[ai][bj][m][0], v1 = acc[ai][bj][m][1];
                        if (rope) {
#pragma unroll
                            for (int j = 0; j < 4; ++j) {
                                const float p0 = __shfl_xor(v0[j], 16), p1 = __shfl_xor(v1[j], 16);
                                if (fq == 0) { v0[j] = v0[j] * c0[j] - p0 * s0[j]; v1[j] = v1[j] * c1[j] - p1 * s1[j]; }
                                else if (fq == 1) { v0[j] = v0[j] * c0[j] + p0 * s0[j]; v1[j] = v1[j] * c1[j] + p1 * s1[j]; }
                            }
                        }
                        v0 = v0 * sc; v1 = v1 * sc;
                        *(v4u*)(dst + (size_t)row * 512 + cb + bj * 128) = pack8(v0, v1);
                    }
                }
        } else if (pn < 6) {
#pragma unroll
            for (int ai = 0; ai < 2; ++ai)
#pragma unroll
                for (int m = 0; m < 4; ++m) {
                    const int row = row0 + ai * 128 + m * 16; const int b = row >> 13, pos = row & (SEQ - 1), pp = (pos & ~15) | p16(pos & 15);
#pragma unroll
                    for (int bj = 0; bj < 2; ++bj) {
                        const int h = (pn - 4) * 2 + bj;
                        bf16* base = VdT + ((size_t)((b * 4 + h) * 128 + wc * 32 + 8 * fq)) * SEQ + pp;
#pragma unroll
                        for (int n = 0; n < 2; ++n)
#pragma unroll
                            for (int j = 0; j < 4; ++j) base[(size_t)(4 * n + j) * SEQ] = (bf16)f2bf(acc[ai][bj][m][n][j]);
                    }
                }
        } else if (pn < 14) {
            const int cb = (pn - 6) * 256 + wc * 32 + 8 * fq;
            f32x4 bv[2][2];
#pragma unroll
            for (int bj = 0; bj < 2; ++bj) { bv[bj][0] = *(const f32x4*)(bgate + cb + bj * 128); bv[bj][1] = *(const f32x4*)(bgate + cb + bj * 128 + 4); }
#pragma unroll
            for (int ai = 0; ai < 2; ++ai)
#pragma unroll
                for (int m = 0; m < 4; ++m) {
                    const int row = row0 + ai * 128 + m * 16;
#pragma unroll
                    for (int bj = 0; bj < 2; ++bj) {
                        f32x4 v0 = acc[ai][bj][m][0] + bv[bj][0], v1 = acc[ai][bj][m][1] + bv[bj][1];
#pragma unroll
                        for (int j = 0; j < 4; ++j) { v0[j] = sigmoidf_(v0[j]); v1[j] = sigmoidf_(v1[j]); }
                        *(v4u*)(GATES + (size_t)row * 2048 + cb + bj * 128) = pack8(v0, v1);
                    }
                }
        } else {
#pragma unroll
            for (int bj = 0; bj < 2; ++bj) {
                const int hh = 2 * (pn - 14) + bj;
                if (hh <= 4) {
                    bf16* dst; int ld, cb; float* ss; int sld;
                    if (hh <= 2) { dst = QL; ld = 384; cb = hh * 128; ss = ssq + hh * 4 + wc; sld = 16; } else { dst = KVL; ld = 256; cb = (hh - 3) * 128; ss = sskv + (hh - 3) * 4 + wc; sld = 8; }
                    cb += wc * 32 + 8 * fq;
#pragma unroll
                    for (int ai = 0; ai < 2; ++ai)
#pragma unroll
                        for (int m = 0; m < 4; ++m) {
                            const int row = row0 + ai * 128 + m * 16;
                            const f32x4 v0 = acc[ai][bj][m][0], v1 = acc[ai][bj][m][1];
                            float s = (v0[0] * v0[0] + v0[1] * v0[1]) + (v0[2] * v0[2] + v0[3] * v0[3]) + (v1[0] * v1[0] + v1[1] * v1[1]) + (v1[2] * v1[2] + v1[3] * v1[3]);
                            s += __shfl_xor(s, 16); s += __shfl_xor(s, 32);
                            if (fq == 0) ss[(size_t)row * sld] = s;
                            *(v4u*)(dst + (size_t)row * ld + cb) = pack8(v0, v1);
                        }
                } else if (wc == 0) {
#pragma unroll
                    for (int ai = 0; ai < 2; ++ai)
#pragma unroll
                        for (int m = 0; m < 4; ++m) {
                            const int row = row0 + ai * 128 + m * 16;
                            const f32x4 c0 = *(const f32x4*)(tmc + (size_t)row * 16 + 8 * (fq & 1)), c1 = *(const f32x4*)(tmc + (size_t)row * 16 + 8 * (fq & 1) + 4);
                            const f32x4 s0 = *(const f32x4*)(tms + (size_t)row * 16 + 8 * (fq & 1)), s1 = *(const f32x4*)(tms + (size_t)row * 16 + 8 * (fq & 1) + 4);
                            f32x4 v0 = acc[ai][bj][m][0], v1 = acc[ai][bj][m][1];
#pragma unroll
                            for (int j = 0; j < 4; ++j) {
                                const float p0 = __shfl_xor(v0[j], 32), p1 = __shfl_xor(v1[j], 32);
                                if (fq < 2) { v0[j] = v0[j] * c0[j] - p0 * s0[j]; v1[j] = v1[j] * c1[j] - p1 * s1[j]; }
                                else { v0[j] = v0[j] * c0[j] + p0 * s0[j]; v1[j] = v1[j] * c1[j] + p1 * s1[j]; }
                            }
                            const v4u w = pack8(v0, v1);
#pragma unroll
                            for (int h = 0; h < 8; ++h) *(v4u*)(Km + (size_t)row * 768 + h * 96 + 64 + 8 * fq) = w;
                        }
                }
            }
        }
    }
};
struct EpiQup {
    static constexpr bool PERM = false, AFTER_DRAIN = false;
    bf16* Qm; const float *ssq, *tmc, *tms;
    __device__ __forceinline__ void operator()(const f32x4 (&acc)[2][2][4][2], const Unit& u, int wr, int wc, int fr, int fq) const {
        const int row0 = u.pm * 256 + wr * 64 + fr;
#pragma unroll
        for (int ai = 0; ai < 2; ++ai)
#pragma unroll
            for (int m = 0; m < 4; ++m) {
                const int row = row0 + ai * 128 + m * 16;
                const f32x4 pa = *(const f32x4*)(ssq + (size_t)row * 16), pb = *(const f32x4*)(ssq + (size_t)row * 16 + 4), pc = *(const f32x4*)(ssq + (size_t)row * 16 + 8);
                const float sq = ((pa[0] + pa[1]) + (pa[2] + pa[3])) + ((pb[0] + pb[1]) + (pb[2] + pb[3])) + ((pc[0] + pc[1]) + (pc[2] + pc[3]));
                const float rs = rsqrtf(sq * (1.f / 384.f) + EPS) * QS_M;
#pragma unroll
                for (int bj = 0; bj < 2; ++bj) {
                    const int gi = 8 * u.pn + 4 * bj + wc, part = gi % 3;
                    f32x4 v0 = acc[ai][bj][m][0] * rs, v1 = acc[ai][bj][m][1] * rs;
                    if (part == 2) {
                        const f32x4 c = *(const f32x4*)(tmc + (size_t)row * 16 + 4 * fq), s = *(const f32x4*)(tms + (size_t)row * 16 + 4 * fq);
                        const f32x4 o0 = v0 * c - v1 * s, o1 = v1 * c + v0 * s; v0 = o0; v1 = o1;
                    }
                    bf16* p = Qm + (size_t)row * 768 + 32 * gi + 4 * fq;
                    *(v2u*)p = pack4(v0); *(v2u*)(p + 16) = pack4(v1);
                }
                asm volatile("" ::: "memory");
            }
    }
};
struct EpiKVup {
    static constexpr bool PERM = false, AFTER_DRAIN = false;
    bf16 *Km, *VmT; const float* sskv;
    __device__ __forceinline__ void operator()(const f32x4 (&acc)[2][2][4][2], const Unit& u, int wr, int wc, int fr, int fq) const {
        const int row0 = u.pm * 256 + wr * 64 + fr;
#pragma unroll
        for (int ai = 0; ai < 2; ++ai)
#pragma unroll
            for (int m = 0; m < 4; ++m) {
                const int row = row0 + ai * 128 + m * 16; const int b = row >> 13, pos = row & (SEQ - 1), pp = (pos & ~15) | p16(pos & 15);
                const f32x4 pa = *(const f32x4*)(sskv + (size_t)row * 8), pb = *(const f32x4*)(sskv + (size_t)row * 8 + 4);
                const float rs = rsqrtf((((pa[0] + pa[1]) + (pa[2] + pa[3])) + ((pb[0] + pb[1]) + (pb[2] + pb[3]))) * (1.f / 256.f) + EPS);
#pragma unroll
                for (int bj = 0; bj < 2; ++bj) {
                    const int head = 2 * u.pn + bj;
                    const f32x4 v0 = acc[ai][bj][m][0] * rs, v1 = acc[ai][bj][m][1] * rs;
                    if (wc < 2) {
                        bf16* p = Km + (size_t)row * 768 + head * 96 + 32 * wc + 4 * fq;
                        *(v2u*)p = pack4(v0); *(v2u*)(p + 16) = pack4(v1);
                    } else {
                        bf16* base = VmT + ((size_t)((b * 8 + head) * 64 + 32 * (wc - 2) + 4 * fq)) * SEQ + pp;
#pragma unroll
                        for (int j = 0; j < 4; ++j) { base[(size_t)j * SEQ] = (bf16)f2bf(v0[j]); base[(size_t)(16 + j) * SEQ] = (bf16)f2bf(v1[j]); }
                    }
                }
                asm volatile("" ::: "memory");
            }
    }
};
template <int STEP> struct EpiBranch {
    static constexpr bool PERM = false, AFTER_DRAIN = false;
    const bf16* GATES; float* TMP; bf16* MERGED;
    __device__ __forceinline__ void operator()(const f32x4 (&acc)[2][2][4][2], const Unit& u, int wr, int wc, int fr, int fq) const {
        const int row0 = u.pm * 256 + wr * 64 + fr, col0 = u.pn * 256 + wc * 32 + 4 * fq;
#pragma unroll
        for (int ai = 0; ai < 2; ++ai)
#pragma unroll
            for (int m = 0; m < 4; ++m) {
                const int row = row0 + ai * 128 + m * 16;
#pragma unroll
                for (int bj = 0; bj < 2; ++bj)
#pragma unroll
                    for (int n = 0; n < 2; ++n) {
                        const int col = col0 + bj * 128 + n * 16;
                        const v2u gw = *(const v2u*)(GATES + (size_t)row * 2048 + STEP * 1024 + col);
                        const f32x4 g = {bf2f(gw.x & 0xffffu), bf2f(gw.x >> 16), bf2f(gw.y & 0xffffu), bf2f(gw.y >> 16)};
                        float* tp = TMP + (size_t)row * 1024 + col;
                        if (STEP == 0) *(f32x4*)tp = acc[ai][bj][m][n] * g;
                        else { const f32x4 t = *(const f32x4*)tp; *(v2u*)(MERGED + (size_t)row * 1024 + col) = pack4(t + acc[ai][bj][m][n] * g); }
                    }
            }
    }
};
struct EpiRes {
    static constexpr bool PERM = false, AFTER_DRAIN = false;
    const float* base; float* out; bf16* outb; float* ss;
    __device__ __forceinline__ void operator()(const f32x4 (&acc)[2][2][4][2], const Unit& u, int wr, int wc, int fr, int fq) const {
        const int row0 = u.pm * 256 + wr * 64 + fr, col0 = u.pn * 256 + wc * 32 + 4 * fq;
#pragma unroll
        for (int ai = 0; ai < 2; ++ai)
#pragma unroll
            for (int m = 0; m < 4; ++m) {
                const int row = row0 + ai * 128 + m * 16; float s = 0.f;
#pragma unroll
                for (int bj = 0; bj < 2; ++bj)
#pragma unroll
                    for (int n = 0; n < 2; ++n) {
                        const size_t off = (size_t)row * 1024 + col0 + bj * 128 + n * 16;
                        const f32x4 v = *(const f32x4*)(base + off) + acc[ai][bj][m][n];
                        s += (v[0] * v[0] + v[1] * v[1]) + (v[2] * v[2] + v[3] * v[3]);
                        *(f32x4*)(out + off) = v;
                        if (outb) *(v2u*)(outb + off) = pack4(v);
                    }
                s += __shfl_xor(s, 16); s += __shfl_xor(s, 32);
                if (fq == 0) ss[(size_t)row * 16 + u.pn * 4 + wc] = s;
            }
    }
};
struct EpiSwiglu {
    static constexpr bool PERM = true, AFTER_DRAIN = false;
    bf16* H; const float* ss1;
    __device__ __forceinline__ void operator()(const f32x4 (&acc)[2][2][4][2], const Unit& u, int wr, int wc, int fr, int fq) const {
        const int row0 = u.pm * 256 + wr * 64 + fr, col0 = u.pn * 128 + wc * 32 + 8 * fq;
#pragma unroll
        for (int ai = 0; ai < 2; ++ai)
#pragma unroll
            for (int m = 0; m < 4; ++m) {
                const int row = row0 + ai * 128 + m * 16;
                float sq = 0.f;
#pragma unroll
                for (int k = 0; k < 4; ++k) { const f32x4 p = *(const f32x4*)(ss1 + (size_t)row * 16 + 4 * k); sq += (p[0] + p[1]) + (p[2] + p[3]); }
                const float rs = rsqrtf(sq * (1.f / 1024.f) + EPS);
                f32x4 o[2];
#pragma unroll
                for (int n = 0; n < 2; ++n) {
                    const f32x4 g = acc[ai][0][m][n] * rs, up = acc[ai][1][m][n] * rs;
#pragma unroll
                    for (int j = 0; j < 4; ++j) o[n][j] = g[j] * sigmoidf_(g[j]) * up[j];
                }
                *(v4u*)(H + (size_t)row * FF + col0) = pack8(o[0], o[1]);
            }
    }
};

template <int DK, int DV>
__device__ __forceinline__ void attn_unit(LAS unsigned char* lds, const bf16* Qp, int ldq, const bf16* Kp, int ldk, const bf16* VTp, bf16* Op, int ldo, int qb) {
    constexpr int KC = DK / 8, KP = DK * 2 + 16, VP = 144, KTB = 64 * KP, BUF = KTB + DV * VP;
    constexpr int KCH = 64 * KC, VCH = DV * 8, NKL = (KCH + 511) / 512, NVL = VCH / 512, NDB = DV / 32;
    const int tid = threadIdx.x, lane = tid & 63, w = __builtin_amdgcn_readfirstlane(tid >> 6), q = lane & 31, hi = lane >> 5;
    const int q0 = qb * 256, NT = 4 * (qb + 1);
    bf16x8 qf[DK / 16];
    { const bf16* qrow = Qp + (size_t)(q0 + 32 * w + q) * ldq + 8 * hi;
#pragma unroll
      for (int c = 0; c < DK / 16; ++c) qf[c] = *(const bf16x8*)(qrow + 16 * c); }
    v4u kreg[NKL], vreg[NVL];
#define ATT_LOAD(t) do { \
    _Pragma("unroll") for (int i_ = 0; i_ < NKL; ++i_) { const int id_ = tid + 512 * i_; if ((KCH % 512 == 0) || id_ < KCH) { const int r_ = id_ / KC, c_ = id_ % KC; kreg[i_] = *(const v4u*)(Kp + (size_t)(64 * (t) + r_) * ldk + c_ * 8); } } \
    _Pragma("unroll") for (int i_ = 0; i_ < NVL; ++i_) { const int id_ = tid + 512 * i_; const int d_ = id_ >> 3, c_ = id_ & 7; vreg[i_] = *(const v4u*)(VTp + (size_t)d_ * SEQ + 64 * (t) + c_ * 8); } } while (0)
#define ATT_STORE(buf) do { \
    _Pragma("unroll") for (int i_ = 0; i_ < NKL; ++i_) { const int id_ = tid + 512 * i_; if ((KCH % 512 == 0) || id_ < KCH) { const int r_ = id_ / KC, c_ = id_ % KC; *(LAS v4u*)(lds + (buf) * BUF + r_ * KP + c_ * 16) = kreg[i_]; } } \
    _Pragma("unroll") for (int i_ = 0; i_ < NVL; ++i_) { const int id_ = tid + 512 * i_; const int d_ = id_ >> 3, c_ = id_ & 7; *(LAS v4u*)(lds + (buf) * BUF + KTB + d_ * VP + c_ * 16) = vreg[i_]; } } while (0)
    ATT_LOAD(0); ATT_STORE(0);
    __syncthreads();
    float mrun = -1e30f, lrun = 0.f;
    f32x16 o[NDB];
#pragma unroll
    for (int db = 0; db < NDB; ++db)
#pragma unroll
        for (int r = 0; r < 16; ++r) o[db][r] = 0.f;
    for (int t = 0; t < NT; ++t) {
        const int buf = t & 1;
        if (t + 1 < NT) ATT_LOAD(t + 1);
        const int tb = t - (NT - 4);
        if (tb < 0 || 64 * tb <= 32 * w + 31) {
            const LAS unsigned char* kb_ = lds + buf * BUF + q * KP + hi * 16;
            f32x16 s0, s1;
#pragma unroll
            for (int r = 0; r < 16; ++r) { s0[r] = 0.f; s1[r] = 0.f; }
#pragma unroll
            for (int c = 0; c < DK / 16; ++c) {
                const bf16x8 a0 = *(const LAS bf16x8*)(kb_ + c * 32), a1 = *(const LAS bf16x8*)(kb_ + 32 * KP + c * 32);
                s0 = __builtin_amdgcn_mfma_f32_32x32x16_bf16(a0, qf[c], s0, 0, 0, 0);
                s1 = __builtin_amdgcn_mfma_f32_32x32x16_bf16(a1, qf[c], s1, 0, 0, 0);
            }
            if (tb >= 0) {
                const int qrel = 32 * w + q, kb0 = 64 * tb + 4 * hi;
#pragma unroll
                for (int r = 0; r < 16; ++r) { const int kv = kb0 + (r & 3) + 8 * (r >> 2); if (kv > qrel) s0[r] = -INFINITY; if (kv + 32 > qrel) s1[r] = -INFINITY; }
            }
            float mx = fmaxf(s0[0], s1[0]);
#pragma unroll
            for (int r = 1; r < 16; ++r) mx = fmaxf(mx, fmaxf(s0[r], s1[r]));
            mx = fmaxf(mx, __shfl_xor(mx, 32));
            const float mn = fmaxf(mrun, mx), alpha = __builtin_amdgcn_exp2f(mrun - mn); mrun = mn;
            float ps = 0.f;
#pragma unroll
            for (int r = 0; r < 16; ++r) { s0[r] = __builtin_amdgcn_exp2f(s0[r] - mn); s1[r] = __builtin_amdgcn_exp2f(s1[r] - mn); ps += s0[r] + s1[r]; }
            lrun = lrun * alpha + ps;
#pragma unroll
            for (int db = 0; db < NDB; ++db)
#pragma unroll
                for (int r = 0; r < 16; ++r) o[db][r] *= alpha;
            const LAS unsigned char* vb_ = lds + buf * BUF + KTB + q * VP + hi * 16;
#pragma unroll
            for (int c4 = 0; c4 < 4; ++c4) {
                v4u pw; const int b8 = 8 * (c4 & 1);
                if (c4 < 2) { pw.x = cvt_pk_bf16(s0[b8 + 0], s0[b8 + 1]); pw.y = cvt_pk_bf16(s0[b8 + 2], s0[b8 + 3]); pw.z = cvt_pk_bf16(s0[b8 + 4], s0[b8 + 5]); pw.w = cvt_pk_bf16(s0[b8 + 6], s0[b8 + 7]); }
                else        { pw.x = cvt_pk_bf16(s1[b8 + 0], s1[b8 + 1]); pw.y = cvt_pk_bf16(s1[b8 + 2], s1[b8 + 3]); pw.z = cvt_pk_bf16(s1[b8 + 4], s1[b8 + 5]); pw.w = cvt_pk_bf16(s1[b8 + 6], s1[b8 + 7]); }
                const bf16x8 pb = __builtin_bit_cast(bf16x8, pw);
#pragma unroll
                for (int db = 0; db < NDB; ++db) {
                    const bf16x8 va = *(const LAS bf16x8*)(vb_ + db * 32 * VP + c4 * 32);
                    o[db] = __builtin_amdgcn_mfma_f32_32x32x16_bf16(va, pb, o[db], 0, 0, 0);
                }
            }
        }
        if (t + 1 < NT) ATT_STORE(buf ^ 1);
        __syncthreads();
    }
#undef ATT_LOAD
#undef ATT_STORE
    lrun += __shfl_xor(lrun, 32);
    const float inv = 1.f / lrun;
    bf16* orow = Op + (size_t)(q0 + 32 * w + q) * ldo + 4 * hi;
#pragma unroll
    for (int db = 0; db < NDB; ++db)
#pragma unroll
        for (int g = 0; g < 4; ++g) {
            const f32x4 v = {o[db][4 * g] * inv, o[db][4 * g + 1] * inv, o[db][4 * g + 2] * inv, o[db][4 * g + 3] * inv};
            *(v2u*)(orow + 32 * db + 8 * g) = pack4(v);
        }
}

__device__ __forceinline__ void tr_item(const float* W, int Nsrc, int src0, const float* g, bf16* WT, int Kdim, int dst_row0, int k0, LAS float* scr, int lane) {
#pragma unroll 8
    for (int i = 0; i < 32; ++i) { const int kk = 2 * i + (lane >> 5); float v = 0.f; if (src0 >= 0) { v = W[(size_t)(k0 + kk) * Nsrc + src0 + (lane & 31)]; if (g) v *= g[k0 + kk]; } scr[kk * 33 + (lane & 31)] = v; }
    LDS_WAIT(); asm volatile("" ::: "memory");
    const int c = lane & 7;
#pragma unroll
    for (int j = 0; j < 4; ++j) { const int n = (lane >> 3) + 8 * j; const LAS float* s = scr + (8 * c) * 33 + n;
        v4u o; o.x = pk2(s[0 * 33], s[1 * 33]); o.y = pk2(s[2 * 33], s[3 * 33]); o.z = pk2(s[4 * 33], s[5 * 33]); o.w = pk2(s[6 * 33], s[7 * 33]);
        *(v4u*)(WT + (size_t)(dst_row0 + n) * Kdim + k0 + 8 * c) = o; }
    LDS_WAIT(); asm volatile("" ::: "memory");
}
__device__ __forceinline__ int inproj_src(int pc) {
    if (pc < 512) return 672 + pc;
    if (pc < 1024) return 1184 + (pc - 512);
    if (pc < 1536) return 1696 + (pc - 1024);
    if (pc < 3584) return 2208 + (pc - 1536);
    if (pc < 3968) return pc - 3584;
    if (pc < 4224) return 384 + (pc - 3968);
    if (pc < 4256) return 640 + (pc - 4224);
    return -1;
}

typedef unsigned v4u_xb __attribute__((ext_vector_type(4)));
#define XB_TMO      128
#define XB_XCNT(j)  (256  + 64 * (j))
#define XB_XSUB(j)  (1280 + 64 * (j))
#define XB_XGEN(j)  (2304 + 64 * (j))
#define XB_TOP      3328
#define XB_TOPGEN   3392
#define XCD_BAR_WORDS 3456
#define XB_SPIN_CAP (1u << 18)

__device__ __forceinline__ unsigned xb_ld(unsigned* p)              { return __hip_atomic_load(p, __ATOMIC_RELAXED, __HIP_MEMORY_SCOPE_AGENT); }
__device__ __forceinline__ unsigned xb_add(unsigned* p, unsigned v) { return __hip_atomic_fetch_add(p, v, __ATOMIC_RELAXED, __HIP_MEMORY_SCOPE_AGENT); }
__device__ __forceinline__ unsigned xb_xcc_id() { return (unsigned)__builtin_amdgcn_s_getreg((3 << 11) | 20) & 0xFu; }
#define XB_SPIN(cond, bar) do { unsigned _sp = 0; while (cond) { __builtin_amdgcn_s_sleep(1); \
    if ((++_sp & 255u) == 0u) { if (xb_ld(&(bar)[XB_TMO])) break; if (_sp > XB_SPIN_CAP) { atomicAdd(&(bar)[XB_TMO], 1u); break; } } } } while (0)

struct XcdBarrier {
    unsigned* bar; unsigned x;
    volatile LAS unsigned* st;
};

__device__ __forceinline__ XcdBarrier xcd_barrier_post(unsigned* bar, volatile LAS unsigned* st) {
    XcdBarrier b; b.bar = bar; b.x = xb_xcc_id(); b.st = st;
    if (threadIdx.x == 0) (void)xb_add(&bar[XB_XCNT(b.x)], 1u);
    return b;
}
__device__ __forceinline__ void xcd_barrier_complete(unsigned* bar, unsigned x, unsigned& nloc, unsigned& nx) {
    const unsigned G = gridDim.x * gridDim.y * gridDim.z;
    unsigned sum, cnt, mine, sp = 0u;
    for (;;) {
        sum = 0u; cnt = 0u; mine = 0u;
#pragma unroll
        for (unsigned j = 0; j < 16; ++j) { const unsigned c = xb_ld(&bar[XB_XCNT(j)]); sum += c; cnt += (c > 0u) ? 1u : 0u; mine = (j == x) ? c : mine; }
        if (sum == G) break;
        __builtin_amdgcn_s_sleep(1);
        if ((++sp & 255u) == 0u) { if (xb_ld(&bar[XB_TMO])) break; if (sp > XB_SPIN_CAP) { atomicAdd(&bar[XB_TMO], 1u); break; } }
    }
    nloc = mine > 0u ? mine : 1u; nx = cnt > 0u ? cnt : 1u;
}

__device__ __forceinline__ void xcd_barrier(const XcdBarrier& b) {
    asm volatile("s_waitcnt vmcnt(0)" ::: "memory");
    __syncthreads();
    if (threadIdx.x == 0) {
        unsigned* bar = b.bar;
        __builtin_amdgcn_s_waitcnt(0);
        unsigned nloc = b.st[0], nx = b.st[1];
        if (nloc == 0u) { xcd_barrier_complete(bar, b.x, nloc, nx); b.st[0] = nloc; b.st[1] = nx; }
        const unsigned old = xb_add(&bar[XB_XSUB(b.x)], 1u);
        const unsigned gen = old / nloc;
        if (old + 1u == (gen + 1u) * nloc) {
            __builtin_amdgcn_fence(__ATOMIC_RELEASE, "agent");
            asm volatile("s_waitcnt vmcnt(0)" ::: "memory");
            const unsigned og = xb_add(&bar[XB_TOP], 1u);
            const unsigned tg = og / nx;
            if (og + 1u == (tg + 1u) * nx) xb_add(&bar[XB_TOPGEN], 1u);
            else XB_SPIN(xb_ld(&bar[XB_TOPGEN]) == tg, bar);
            __builtin_amdgcn_fence(__ATOMIC_ACQUIRE, "agent");
            xb_add(&bar[XB_XGEN(b.x)], 1u);
            asm volatile("s_waitcnt vmcnt(0)" ::: "memory");
        } else {
            XB_SPIN(xb_ld(&bar[XB_XGEN(b.x)]) == gen, bar);
            __builtin_amdgcn_fence(__ATOMIC_ACQUIRE, "agent");
            asm volatile("s_waitcnt vmcnt(0)" ::: "memory");
        }
    }
    __syncthreads();
}

#define GRID_SYNC() do { xcd_barrier(xbar); __builtin_amdgcn_fence(__ATOMIC_ACQUIRE, "agent"); asm volatile("s_waitcnt vmcnt(0)" ::: "memory"); } while (0)
struct Args {
    const float* x; const int* positions; const float *norm_mix_g, *w_in, *b_gate, *mla_q_norm_g, *mla_w_uq, *mla_kv_norm_g, *mla_w_ukv;
    const float *lq1, *lk1, *lq2, *lk2, *subln_g, *w_branch_mla, *w_branch_diff, *w_out, *norm_ffn_g, *w_ffn_gate, *w_ffn_up, *w_ffn_down, *norm_final_g;
    float* out; unsigned char* ws;
};

__global__ void __launch_bounds__(512, 2) fwd_megakernel(Args a) {
    extern __shared__ __attribute__((aligned(16))) unsigned char lds_raw[];
    LAS unsigned char* lds = (LAS unsigned char*)lds_raw;
    cg::grid_group grid = cg::this_grid();
    const int tid = threadIdx.x, lane = tid & 63, wave = __builtin_amdgcn_readfirstlane(tid >> 6);
    const int G = gridDim.x, bx = blockIdx.x;
    const int vcu = (G % 8 == 0) ? (bx % 8) * (G / 8) + bx / 8 : bx;
    const int gw = vcu * 8 + wave, NGW = G * 8;
    unsigned char* ws = a.ws;
    for (int u_ = tid; u_ < 64; u_ += 512) ((LAS unsigned*)(lds + 131072))[u_] = 0u;
    __syncthreads();
    XcdBarrier xbar = xcd_barrier_post((unsigned*)(ws + WS_SS) + 4096, (volatile LAS unsigned*)(lds + 131072 + 32));
    float* ssq = (float*)(ws + WS_PART); float* sskv = ssq + (size_t)M * 16; float* ss1 = sskv + (size_t)M * 16; float* ss2 = ss1 + (size_t)M * 16;
    float* tdc = (float*)(ws + WS_TAB); float* tds = tdc + (size_t)M * 8; float* tmc = tds + (size_t)M * 8; float* tms = tmc + (size_t)M * 16;
    bf16 *W1 = (bf16*)(ws + WS_W1), *W2A = (bf16*)(ws + WS_W2A), *W2B = (bf16*)(ws + WS_W2B), *W3A = (bf16*)(ws + WS_W3A), *W3B = (bf16*)(ws + WS_W3B), *W4 = (bf16*)(ws + WS_W4), *W5 = (bf16*)(ws + WS_W5), *W6 = (bf16*)(ws + WS_W6);
    bf16 *XN = (bf16*)(ws + WS_XN), *QL = (bf16*)(ws + WS_QL), *KVL = (bf16*)(ws + WS_KVL), *OM = (bf16*)(ws + WS_OM), *ODR = (bf16*)(ws + WS_ODR);
    bf16 *QD = (bf16*)(ws + WS_QD), *ODN = (bf16*)(ws + WS_ODN), *KD = (bf16*)(ws + WS_KD), *VDT = (bf16*)(ws + WS_VDT), *MERGED = (bf16*)(ws + WS_MERGED);
    bf16 *QM = (bf16*)(ws + WS_QM), *KM = (bf16*)(ws + WS_KM), *VMT = (bf16*)(ws + WS_VMT), *X1B = (bf16*)(ws + WS_X1B), *HB = (bf16*)(ws + WS_H);
    float* TMP = (float*)(ws + WS_TMP);
    bf16* GATES = (bf16*)a.out;

    if (PH(0)) {
        LAS float* scr = (LAS float*)(lds + wave * 16384);
        constexpr int I1 = 16 * (N1 / 32), I2A = 6 * 24, I2B = 4 * 32, I3 = 8 * 32, I4 = 16 * 32, I5 = 16 * (2 * FF / 32), I6 = (FF / 64) * 32;
        constexpr int NITEMS = I1 + I2A + I2B + 2 * I3 + I4 + I5 + I6;
        for (int it = gw; it < NITEMS; it += NGW) {
            int r = it;
            if (r < I1) { const int nb = r % (N1 / 32), kb = r / (N1 / 32); tr_item(a.w_in, 4256, inproj_src(32 * nb), nullptr, W1, 1024, 32 * nb, 64 * kb, scr, lane); continue; } r -= I1;
            if (r < I2A) { const int nb = r % 24, kb = r / 24; tr_item(a.mla_w_uq, 768, 32 * nb, a.mla_q_norm_g, W2A, 384, 32 * nb, 64 * kb, scr, lane); continue; } r -= I2A;
            if (r < I2B) { const int nb = r % 32, kb = r / 32; tr_item(a.mla_w_ukv, 1024, 32 * nb, a.mla_kv_norm_g, W2B, 256, 32 * nb, 64 * kb, scr, lane); continue; } r -= I2B;
            if (r < I3) { const int nb = r % 32, kb = r / 32; tr_item(a.w_branch_mla, 1024, 32 * nb, nullptr, W3A, 512, 32 * nb, 64 * kb, scr, lane); continue; } r -= I3;
            if (r < I3) { const int nb = r % 32, kb = r / 32; tr_item(a.w_branch_diff, 1024, 32 * nb, nullptr, W3B, 512, 32 * nb, 64 * kb, scr, lane); continue; } r -= I3;
            if (r < I4) { const int nb = r % 32, kb = r / 32; tr_item(a.w_out, 1024, 32 * nb, nullptr, W4, 1024, 32 * nb, 64 * kb, scr, lane); continue; } r -= I4;
            if (r < I5) { const int nb = r % (2 * FF / 32), kb = r / (2 * FF / 32); const int pc = 32 * nb, tile = pc >> 8, inner = pc & 255;
                const float* W = inner < 128 ? a.w_ffn_gate : a.w_ffn_up; tr_item(W, FF, 128 * tile + (inner & 127), a.norm_ffn_g, W5, 1024, pc, 64 * kb, scr, lane); continue; } r -= I5;
            { const int nb = r % 32, kb = r / 32; tr_item(a.w_ffn_down, 1024, 32 * nb, nullptr, W6, FF, 32 * nb, 64 * kb, scr, lane); }
        }
        for (int m = gw; m < M; m += NGW) {
            const f32x4* xr = (const f32x4*)(a.x + (size_t)m * D) + lane; const f32x4* gr = (const f32x4*)a.norm_mix_g + lane;
            f32x4 v[4]; float s = 0.f;
#pragma unroll
            for (int j = 0; j < 4; ++j) { v[j] = xr[64 * j]; s += (v[j][0] * v[j][0] + v[j][1] * v[j][1]) + (v[j][2] * v[j][2] + v[j][3] * v[j][3]); }
            const float rs = rsqrtf(wave_sum(s) * (1.f / D) + EPS);
            v2u* o8 = (v2u*)(XN + (size_t)m * D) + lane;
#pragma unroll
            for (int j = 0; j < 4; ++j) o8[64 * j] = pack4(v[j] * rs * gr[64 * j]);
        }
        const int gt = vcu * 512 + tid, NGT = G * 512;
        for (int i = gt; i < M * 24; i += NGT) {
            const int tok = i / 24, f = i % 24; const float pos = (float)a.positions[tok];
            const bool dm = f >= 8; const int fi = dm ? f - 8 : f;
            const float inv = expf((-13.122363377404328f * (float)fi) * (dm ? (2.0f / 32.0f) : (2.0f / 16.0f)));
            const float ang = pos * inv;
            const double ad = (double)ang, kd = rint(ad * 0.15915494309189535), rd = ad - kd * 6.283185307179586;
            const float rr = (float)rd, cs = __cosf(rr), sn = __sinf(rr);
            if (dm) { tmc[(size_t)tok * 16 + fi] = cs; tms[(size_t)tok * 16 + fi] = sn; } else { tdc[(size_t)tok * 8 + fi] = cs; tds[(size_t)tok * 8 + fi] = sn; }
        }
    }
    GRID_SYNC();
    grid.sync();

    if (PH(1)) {
        pg8::Gemm g{XN, W1, M, N1, D}; pg8::StaticOrder S; S.init(M, N1, G, bx);
        EpiInProj E{QD, KD, VDT, GATES, QL, KVL, KM, a.b_gate, tdc, tds, tmc, tms, ssq, sskv};
        pg8::gemm_phase<EpiInProj, pg8::StaticOrder, true, true>(lds, g, S, E);
    }
    GRID_SYNC();

    if (PH(2)) {
        pg8::Gemm g{KVL, W2B, M, 1024, 256}; pg8::StaticOrder S; S.init(M, 1024, G, bx);
        EpiKVup E{KM, VMT, sskv};
        pg8::gemm_phase<EpiKVup, pg8::StaticOrder, true, true>(lds, g, S, E);
    }
    __syncthreads();
    if (PH(3)) {
        pg8::Gemm g{QL, W2A, M, 768, 384}; pg8::StaticOrder S; S.init(M, 768, G, bx);
        EpiQup E{QM, ssq, tmc, tms};
        pg8::gemm_phase<EpiQup, pg8::StaticOrder, true, true>(lds, g, S, E);
    }
    GRID_SYNC();

    if (PH(4)) for (int j = vcu; j < 1024; j += G) {
        const int i = j >> 8, v = j & 255, bh = v >> 4, s = v & 15;
        if (i < 2) {
            const int b = bh >> 3, h = bh & 7, qb = (i == 0) ? s : 31 - s;
            attn_unit<96, 64>(lds, QM + (size_t)b * SEQ * 768 + h * 96, 768, KM + (size_t)b * SEQ * 768 + h * 96, 768, VMT + (size_t)(b * 8 + h) * 64 * SEQ, OM + (size_t)b * SEQ * 512 + h * 64, 512, qb);
        } else {
            const int b = bh >> 3, h = (bh >> 1) & 3, c = bh & 1, qb = (i == 2) ? 15 - s : 16 + s;
            attn_unit<64, 128>(lds, QD + (size_t)b * SEQ * 512 + (h * 2 + c) * 64, 512, KD + (size_t)b * SEQ * 512 + (h * 2 + c) * 64, 512, VDT + (size_t)(b * 4 + h) * 128 * SEQ, ODR + (size_t)b * SEQ * 1024 + (h * 2 + c) * 128, 1024, qb);
        }
    }
    GRID_SYNC();

    if (PH(5)) {
        pg8::Gemm g{OM, W3A, M, D, 512}; pg8::StaticOrder S; S.init(M, D, G, bx);
        EpiBranch<0> E{GATES, TMP, MERGED};
        pg8::gemm_phase<EpiBranch<0>, pg8::StaticOrder, true, true>(lds, g, S, E);
    }
    if (PH(6)) {
        const float d1 = wave_sum(a.lq1[lane] * a.lk1[lane]), d2 = wave_sum(a.lq2[lane] * a.lk2[lane]);
        const float lam = expf(d1) - expf(d2) + LAMBDA_INIT;
        f32x4 g0 = *(const f32x4*)(a.subln_g + 8 * (lane & 15)), g1 = *(const f32x4*)(a.subln_g + 8 * (lane & 15) + 4);
        g0 = g0 * (1.f - LAMBDA_INIT); g1 = g1 * (1.f - LAMBDA_INIT);
        for (int m = gw; m < M; m += NGW) {
            const int h = lane >> 4, dd = 8 * (lane & 15);
            const v4u w1 = *(const v4u*)(ODR + (size_t)m * 1024 + h * 256 + dd), w2 = *(const v4u*)(ODR + (size_t)m * 1024 + h * 256 + 128 + dd);
            float v[8];
#pragma unroll
            for (int k = 0; k < 4; ++k) { v[2 * k] = bf2f(w1[k] & 0xffffu) - lam * bf2f(w2[k] & 0xffffu); v[2 * k + 1] = bf2f(w1[k] >> 16) - lam * bf2f(w2[k] >> 16); }
            float s = 0.f;
#pragma unroll
            for (int k = 0; k < 8; ++k) s += v[k] * v[k];
            s += __shfl_xor(s, 1); s += __shfl_xor(s, 2); s += __shfl_xor(s, 4); s += __shfl_xor(s, 8);
            const float rs = rsqrtf(s * (1.f / 128.f) + EPS);
            const f32x4 o0 = {v[0] * rs * g0[0], v[1] * rs * g0[1], v[2] * rs * g0[2], v[3] * rs * g0[3]}, o1 = {v[4] * rs * g1[0], v[5] * rs * g1[1], v[6] * rs * g1[2], v[7] * rs * g1[3]};
            *(v4u*)(ODN + (size_t)m * 512 + h * 128 + dd) = pack8(o0, o1);
        }
    }
    GRID_SYNC();

    if (PH(7)) {
        pg8::Gemm g{ODN, W3B, M, D, 512}; pg8::StaticOrder S; S.init(M, D, G, bx);
        EpiBranch<1> E{GATES, TMP, MERGED};
        pg8::gemm_phase<EpiBranch<1>, pg8::StaticOrder, true, true>(lds, g, S, E);
    }
    GRID_SYNC();

    if (PH(8)) {
        pg8::Gemm g{MERGED, W4, M, D, D}; pg8::StaticOrder S; S.init(M, D, G, bx);
        EpiRes E{a.x, a.out, X1B, ss1};
        pg8::gemm_phase<EpiRes, pg8::StaticOrder, true, true>(lds, g, S, E);
    }
    GRID_SYNC();

    if (PH(9)) {
        pg8::Gemm g{X1B, W5, M, 2 * FF, D}; pg8::StaticOrder S; S.init(M, 2 * FF, G, bx);
        EpiSwiglu E{HB, ss1};
        pg8::gemm_phase<EpiSwiglu, pg8::StaticOrder, true, true>(lds, g, S, E);
    }
    GRID_SYNC();

    if (PH(10)) {
        pg8::Gemm g{HB, W6, M, D, FF}; pg8::StaticOrder S; S.init(M, D, G, bx);
        EpiRes E{a.out, a.out, nullptr, ss2};
        pg8::gemm_phase<EpiRes, pg8::StaticOrder, true, true>(lds, g, S, E);
    }
    GRID_SYNC();

    if (PH(11)) for (int m = gw; m < M; m += NGW) {
        f32x4* xr = (f32x4*)(a.out + (size_t)m * D) + lane; const f32x4* gr = (const f32x4*)a.norm_final_g + lane;
        float sq = ss2[(size_t)m * 16 + (lane & 15)];
        sq += __shfl_xor(sq, 1); sq += __shfl_xor(sq, 2); sq += __shfl_xor(sq, 4); sq += __shfl_xor(sq, 8);
        const float rs = rsqrtf(sq * (1.f / D) + EPS);
#pragma unroll
        for (int j = 0; j < 4; ++j) xr[64 * j] = xr[64 * j] * rs * gr[64 * j];
    }
}

extern "C" void kernel_launch(void* const* d_in, const int* in_sizes, int n_in, void* d_out, int out_size, void* d_ws, size_t ws_size, hipStream_t stream) {
    static int grid = 0;
    if (grid == 0) {
        if (n_in != 22 || in_sizes[0] != M * D || out_size != M * D || ws_size < WS_END) { fprintf(stderr, "kernel_launch: unexpected shapes (n_in %d, ws %zu)\n", n_in, ws_size); grid = -1; return; }
        int dev = 0, cus = 0, per_cu = 0;
        hipGetDevice(&dev); hipDeviceGetAttribute(&cus, hipDeviceAttributeMultiprocessorCount, dev);
        hipFuncSetAttribute((const void*)fwd_megakernel, hipFuncAttributeMaxDynamicSharedMemorySize, LDS_BYTES);
        hipOccupancyMaxActiveBlocksPerMultiprocessor(&per_cu, (const void*)fwd_megakernel, 512, LDS_BYTES);
        if (per_cu < 1) { fprintf(stderr, "kernel_launch: occupancy query says %d blocks per CU\n", per_cu); per_cu = 1; }
        grid = cus * (per_cu > 1 ? 1 : per_cu);
        (void)hipGetLastError();
    }
    if (grid < 0) return;
    if (hipMemsetAsync(d_ws, 0, 65536, stream) != hipSuccess) { fprintf(stderr, "kernel_launch: memset failed\n"); return; }
    Args a{};
    a.x = (const float*)d_in[0]; a.positions = (const int*)d_in[1]; a.norm_mix_g = (const float*)d_in[2]; a.w_in = (const float*)d_in[3]; a.b_gate = (const float*)d_in[4];
    a.mla_q_norm_g = (const float*)d_in[5]; a.mla_w_uq = (const float*)d_in[6]; a.mla_kv_norm_g = (const float*)d_in[7]; a.mla_w_ukv = (const float*)d_in[8];
    a.lq1 = (const float*)d_in[9]; a.lk1 = (const float*)d_in[10]; a.lq2 = (const float*)d_in[11]; a.lk2 = (const float*)d_in[12]; a.subln_g = (const float*)d_in[13];
    a.w_branch_mla = (const float*)d_in[14]; a.w_branch_diff = (const float*)d_in[15]; a.w_out = (const float*)d_in[16]; a.norm_ffn_g = (const float*)d_in[17];
    a.w_ffn_gate = (const float*)d_in[18]; a.w_ffn_up = (const float*)d_in[19]; a.w_ffn_down = (const float*)d_in[20]; a.norm_final_g = (const float*)d_in[21];
    a.out = (float*)d_out; a.ws = (unsigned char*)d_ws;
    void* args[] = {&a};
    hipError_t e = hipLaunchCooperativeKernel((const void*)fwd_megakernel, dim3(grid), dim3(512), args, LDS_BYTES, stream);
    if (e != hipSuccess) fprintf(stderr, "cooperative launch failed: %s (grid %d)\n", hipGetErrorString(e), grid);
}
```

```cpp
#include <hip/hip_runtime.h>
#include <hip/hip_cooperative_groups.h>
#include <cstdio>
#include <cstdint>
namespace cg = cooperative_groups;
namespace pg8 {
#define PG8_LAS __attribute__((address_space(3)))
typedef unsigned short bf16_t;
typedef short bf16x8 __attribute__((ext_vector_type(8)));
typedef float f32x4 __attribute__((ext_vector_type(4)));
typedef unsigned u32x4 __attribute__((ext_vector_type(4)));
constexpr int BM = 256, BK = 64, HALF = 128, HTB = HALF * BK * 2  , STAGE_BYTES = 8 * HTB, NXCD = 8, WGM = 8;

__host__ __device__ __forceinline__ int lds_byte(int r, int c) { const int st = (r >> 4) * 2 + (c >> 5), rr = r & 15, cc = c & 31, ob = rr * 64 + cc * 2; return st * 1024 + (ob ^ (((ob >> 9) & 1) << 5)); }
__host__ __device__ __forceinline__ void stage_rc(int b, int& R, int& C) { const int st = b / 1024, sb = b % 1024, swz = sb ^ (((sb >> 9) & 1) << 5); R = (st >> 1) * 16 + swz / 64; C = (st & 1) * 32 + (swz % 64) / 2; }
__host__ __device__ __forceinline__ int perm32(int rho) { const int n = rho >> 4, i = rho & 15; return 8 * (i >> 2) + 4 * n + (i & 3); }

struct Unit { int pm, pn; };
struct Gemm { const bf16_t* A; const bf16_t* Bt; int M, N, K; };

struct StaticOrder {
    int nM, nN, nwg, G, c;
    __host__ __device__ void init(int M, int N, int G_, int c_) { nM = M / BM; nN = N / BM; nwg = nM * nN; G = G_; c = c_; }
    __host__ __device__ bool next(int i, Unit& u) const {
        const long L = (long)i * G + c; if (L >= nwg) return false;
        int wgid = (int)L; { const int q = nwg / NXCD, r = nwg % NXCD, xcd = wgid % NXCD, off = wgid / NXCD; wgid = (xcd < r ? xcd * (q + 1) : r * (q + 1) + (xcd - r) * q) + off; }
        const int nig = WGM * nN, gid = wgid / nig, fm = gid * WGM, gsz = (nM - fm) < WGM ? (nM - fm) : WGM;
        u.pm = fm + ((wgid % nig) % gsz); u.pn = (wgid % nig) / gsz; return true;
    }
    __device__ __forceinline__ void a_ready(const Unit&) const {}
    __device__ __forceinline__ void done(const Unit&) const {}
};

typedef float f32x2_t __attribute__((ext_vector_type(2))); typedef __bf16 bf16x2_t __attribute__((ext_vector_type(2)));
__device__ __forceinline__ unsigned cvt_pk_bf16(float lo, float hi) { f32x2_t v = {lo, hi}; bf16x2_t b = __builtin_convertvector(v, bf16x2_t); return __builtin_bit_cast(unsigned, b); }
typedef float f32x2 __attribute__((ext_vector_type(2)));
template <class Epi, class Sched, bool ALIGN_EPI = false, bool SP2 = false>
__device__ __forceinline__ void gemm_phase(PG8_LAS unsigned char* lds, const Gemm g, const Sched& S, const Epi& E) {
    const int tid = threadIdx.x, wid = __builtin_amdgcn_readfirstlane(tid >> 6), lane = tid & 63, wr = wid >> 2, wc = wid & 3, fr = lane & 15, fq = lane >> 4;
    const int K = g.K, nt = K / BK;
    unsigned voffA[2], voffB[2];
#pragma unroll
    for (int i = 0; i < 2; ++i) { int R, C; stage_rc(tid * 16 + i * 8192, R, C); const int Rb = Epi::PERM ? ((R & ~31) + perm32(R & 31)) : R;
        voffA[i] = (unsigned)(R * K + C) * 2u; voffB[i] = (unsigned)(Rb * K + C) * 2u; }
    const size_t kstep = (size_t)(BK * 2);
    const size_t hstep = (size_t)HALF * K * 2;
    const size_t tstep = 2 * hstep;
    const unsigned ldsw = (unsigned)wid * 1024u;
    const int aoff = lds_byte(wr * 64 + fr, fq * 8), boff = lds_byte(wc * 32 + fr, fq * 8);
#define PG8_SA(b, h) (((b) * 2 + (h)) * HTB)
#define PG8_SB(b, h) ((4 + (b) * 2 + (h)) * HTB)
#define PG8_STAGE(bufoff, gbase, voff) do { _Pragma("unroll") for (int _i = 0; _i < 2; ++_i) \
        __builtin_amdgcn_global_load_lds((const unsigned*)((const char*)(gbase) + (voff)[_i]), (PG8_LAS unsigned*)(lds + (bufoff) + ldsw + _i * 8192), 16, 0, 0); } while (0)
#define PG8_LDA(dst, b, h) do { _Pragma("unroll") for (int m = 0; m < 4; ++m) _Pragma("unroll") for (int k = 0; k < 2; ++k) dst[m][k] = *(const PG8_LAS bf16x8*)(lds + PG8_SA(b, h) + aoff + m * 2048 + k * 1024); } while (0)
#define PG8_LDB(dst, b, h) do { _Pragma("unroll") for (int n = 0; n < 2; ++n) _Pragma("unroll") for (int k = 0; k < 2; ++k) dst[n][k] = *(const PG8_LAS bf16x8*)(lds + PG8_SB(b, h) + boff + n * 2048 + k * 1024); } while (0)
#define PG8_MMA(ai, bj, At, Bt) do { __builtin_amdgcn_s_setprio(1); _Pragma("unroll") for (int m = 0; m < 4; ++m) _Pragma("unroll") for (int n = 0; n < 2; ++n) _Pragma("unroll") for (int k = 0; k < 2; ++k) \
        acc[ai][bj][m][n] = __builtin_amdgcn_mfma_f32_16x16x32_bf16(Bt[n][k], At[m][k], acc[ai][bj][m][n], 0, 0, 0); __builtin_amdgcn_s_setprio(0); } while (0)
#define PG8_WAIT_V(n) asm volatile("s_waitcnt vmcnt(" #n ")" ::: "memory")
#define PG8_WAIT_L(n) asm volatile("s_waitcnt lgkmcnt(" #n ")" ::: "memory")
#define PG8_BAR __builtin_amdgcn_s_barrier()
#define PG8_SCHED __builtin_amdgcn_sched_barrier(0)
    Unit cur, nxt; int ui = 0;
    if (!S.next(0, cur)) return;
    f32x4 acc[2][2][4][2];
#pragma unroll
    for (int a = 0; a < 2; ++a)
#pragma unroll
        for (int b = 0; b < 2; ++b)
#pragma unroll
            for (int m = 0; m < 4; ++m)
#pragma unroll
                for (int n = 0; n < 2; ++n) acc[a][b][m][n] = (f32x4){0.f, 0.f, 0.f, 0.f};
    bf16x8 At[4][2], B0[2][2], B1[2][2];
    const char* cA = (const char*)g.A + (size_t)cur.pm * tstep; const char* cB = (const char*)g.Bt + (size_t)cur.pn * tstep;
    S.a_ready(cur);
    if constexpr (SP2) {
        PG8_STAGE(PG8_SB(0, 0), cB, voffB); PG8_STAGE(PG8_SB(0, 1), cB + hstep, voffB); PG8_STAGE(PG8_SA(0, 0), cA, voffA); PG8_STAGE(PG8_SA(0, 1), cA + hstep, voffA);
        if (wr == 1) PG8_BAR;
        PG8_WAIT_V(2); PG8_BAR;
        PG8_STAGE(PG8_SB(1, 0), cB + kstep, voffB); PG8_STAGE(PG8_SA(1, 0), cA + kstep, voffA); PG8_STAGE(PG8_SB(1, 1), cB + hstep + kstep, voffB);
        PG8_WAIT_V(6); PG8_BAR;
    } else {
        PG8_STAGE(PG8_SB(0, 0), cB, voffB); PG8_STAGE(PG8_SA(0, 0), cA, voffA); PG8_STAGE(PG8_SB(0, 1), cB + hstep, voffB); PG8_STAGE(PG8_SA(0, 1), cA + hstep, voffA);
        if (wr == 1) PG8_BAR;
        PG8_WAIT_V(4); PG8_BAR;
        PG8_STAGE(PG8_SB(1, 0), cB + kstep, voffB); PG8_STAGE(PG8_SA(1, 0), cA + kstep, voffA); PG8_STAGE(PG8_SB(1, 1), cB + hstep + kstep, voffB);
        PG8_WAIT_V(6); PG8_BAR;
    }
    for (;;) {
        const bool has_next = S.next(ui + 1, nxt);
        const char* nA = has_next ? (const char*)g.A + (size_t)nxt.pm * tstep : cA; const char* nB = has_next ? (const char*)g.Bt + (size_t)nxt.pn * tstep : cB;
#pragma unroll 1
        for (int t = 0; t < nt; t += 2) {
            const bool last = (t == nt - 2);
            const char* a1 = cA + (size_t)(t + 1) * kstep;
            const char* a2 = last ? nA : cA + (size_t)(t + 2) * kstep; const char* b2 = last ? nB : cB + (size_t)(t + 2) * kstep;
            const char* a3 = a2 + kstep; const char* b3 = b2 + kstep;
            if (last && has_next) S.a_ready(nxt);
            if constexpr (SP2) {
            PG8_LDB(B0, 0, 0); PG8_LDB(B1, 0, 1); PG8_SCHED; PG8_LDA(At, 0, 0); PG8_STAGE(PG8_SA(1, 1), a1 + hstep, voffA);
            PG8_WAIT_V(8); PG8_WAIT_L(0); PG8_BAR; PG8_MMA(0, 0, At, B0); PG8_MMA(0, 1, At, B1); PG8_BAR; PG8_SCHED;
            PG8_LDA(At, 0, 1); PG8_STAGE(PG8_SB(0, 0), b2, voffB); PG8_STAGE(PG8_SB(0, 1), b2 + hstep, voffB); PG8_STAGE(PG8_SA(0, 0), a2, voffA);
            PG8_WAIT_V(8); PG8_WAIT_L(0); PG8_BAR; PG8_MMA(1, 0, At, B0); PG8_MMA(1, 1, At, B1); PG8_BAR; PG8_SCHED;
            PG8_LDB(B0, 1, 0); PG8_LDB(B1, 1, 1); PG8_SCHED; PG8_LDA(At, 1, 0); PG8_STAGE(PG8_SA(0, 1), a2 + hstep, voffA);
            PG8_WAIT_V(8); PG8_WAIT_L(0); PG8_BAR; PG8_MMA(0, 0, At, B0); PG8_MMA(0, 1, At, B1); PG8_BAR; PG8_SCHED;
            PG8_LDA(At, 1, 1); PG8_STAGE(PG8_SB(1, 0), b3, voffB); PG8_STAGE(PG8_SB(1, 1), b3 + hstep, voffB); PG8_STAGE(PG8_SA(1, 0), a3, voffA);
            PG8_WAIT_V(8); PG8_WAIT_L(0); PG8_BAR; PG8_MMA(1, 0, At, B0); PG8_MMA(1, 1, At, B1); PG8_BAR; PG8_SCHED;
            } else {
            PG8_LDB(B0, 0, 0); PG8_SCHED; PG8_LDA(At, 0, 0); PG8_STAGE(PG8_SA(1, 1), a1 + hstep, voffA);
            PG8_WAIT_L(8); PG8_BAR; PG8_WAIT_L(0); PG8_MMA(0, 0, At, B0); PG8_BAR; PG8_SCHED;
            PG8_LDB(B1, 0, 1); PG8_STAGE(PG8_SB(0, 0), b2, voffB);
            PG8_BAR; PG8_WAIT_L(0); PG8_MMA(0, 1, At, B1); PG8_BAR;
            PG8_LDA(At, 0, 1); PG8_STAGE(PG8_SA(0, 0), a2, voffA);
            PG8_BAR; PG8_WAIT_L(0); PG8_MMA(1, 0, At, B0); PG8_BAR; PG8_SCHED;
            PG8_STAGE(PG8_SB(0, 1), b2 + hstep, voffB);
            PG8_WAIT_V(6); PG8_BAR; PG8_MMA(1, 1, At, B1); PG8_BAR;
            PG8_LDB(B0, 1, 0); PG8_SCHED; PG8_LDA(At, 1, 0); PG8_STAGE(PG8_SA(0, 1), a2 + hstep, voffA);
            PG8_WAIT_L(8); PG8_BAR; PG8_WAIT_L(0); PG8_MMA(0, 0, At, B0); PG8_BAR; PG8_SCHED;
            PG8_LDB(B1, 1, 1); PG8_STAGE(PG8_SB(1, 0), b3, voffB);
            PG8_BAR; PG8_WAIT_L(0); PG8_MMA(0, 1, At, B1); PG8_BAR;
            PG8_LDA(At, 1, 1); PG8_STAGE(PG8_SA(1, 0), a3, voffA);
            PG8_BAR; PG8_WAIT_L(0); PG8_MMA(1, 0, At, B0); PG8_BAR; PG8_SCHED;
            PG8_STAGE(PG8_SB(1, 1), b3 + hstep, voffB);
            PG8_WAIT_V(6); PG8_BAR; PG8_MMA(1, 1, At, B1); PG8_BAR;
            }
        }
        if constexpr (ALIGN_EPI) { if (wr == 0) PG8_BAR; }
        if constexpr (!Epi::AFTER_DRAIN) { E(acc, cur, wr, wc, fr, fq); S.done(cur); }
        if (!has_next) break;
#pragma unroll
        for (int a = 0; a < 2; ++a)
#pragma unroll
            for (int b = 0; b < 2; ++b)
#pragma unroll
                for (int m = 0; m < 4; ++m)
#pragma unroll
                    for (int n = 0; n < 2; ++n) acc[a][b][m][n] = (f32x4){0.f, 0.f, 0.f, 0.f};
        cur = nxt; cA = nA; cB = nB; ++ui;
        if constexpr (ALIGN_EPI) { if (wr == 1) PG8_BAR; }
    }
    PG8_WAIT_V(0);
    if constexpr (!ALIGN_EPI) { if (wr == 0) PG8_BAR; }
    PG8_BAR;
    if constexpr (Epi::AFTER_DRAIN) { E.fused(acc, cur, wr, wc, fr, fq, lds, wid, lane); S.done(cur); }
#undef PG8_SA
#undef PG8_SB
#undef PG8_STAGE
#undef PG8_LDA
#undef PG8_LDB
#undef PG8_MMA
#undef PG8_WAIT_V
#undef PG8_WAIT_L
#undef PG8_BAR
#undef PG8_SCHED
}
}

#ifndef PH_MASK
#define PH_MASK 0xFFFF
#endif
#define PH(k) ((PH_MASK >> (k)) & 1)
constexpr int NB = 2, SEQ = 8192, M = NB * SEQ, D = 1024;
constexpr int N1 = 4352;
constexpr int FF = 2816;
constexpr float EPS = 1e-6f;
constexpr float LOG2E = 1.4426950408889634f;
constexpr float QS_M = 0.10206207261596577f * LOG2E;
constexpr float QS_D = 0.125f * LOG2E;
constexpr float LAMBDA_INIT = 0.2f;

constexpr size_t MiB = 1u << 20;
constexpr size_t WS_SS = 0;
constexpr size_t WS_TAB = 1 * MiB;
constexpr size_t WS_W1 = 4 * MiB, WS_W2A = 13 * MiB, WS_W2B = 14 * MiB, WS_W3A = 15 * MiB, WS_W3B = 16 * MiB, WS_W4 = 17 * MiB, WS_W5 = 19 * MiB, WS_W6 = 30 * MiB;
constexpr size_t WS_XN = 36 * MiB, WS_QL = 68 * MiB, WS_KVL = 80 * MiB;
constexpr size_t WS_OM = 36 * MiB, WS_ODR = 52 * MiB;
constexpr size_t WS_QD = 88 * MiB, WS_ODN = 88 * MiB;
constexpr size_t WS_KD = 104 * MiB, WS_VDT = 120 * MiB, WS_MERGED = 104 * MiB;
constexpr size_t WS_QM = 136 * MiB, WS_KM = 160 * MiB, WS_VMT = 184 * MiB, WS_TMP = 136 * MiB;
constexpr size_t WS_X1B = 200 * MiB;
constexpr size_t WS_H = 36 * MiB;
constexpr size_t WS_PART = 232 * MiB;
constexpr size_t WS_END = 236 * MiB;

constexpr int LDS_BYTES = 147456;

#define LAS __attribute__((address_space(3)))
typedef unsigned short bf16;
typedef unsigned v4u __attribute__((ext_vector_type(4)));
typedef unsigned v2u __attribute__((ext_vector_type(2)));
typedef float f32x4 __attribute__((ext_vector_type(4)));
typedef float f32x16 __attribute__((ext_vector_type(16)));
typedef short bf16x8 __attribute__((ext_vector_type(8)));
using pg8::cvt_pk_bf16;
#define LDS_WAIT() asm volatile("s_waitcnt lgkmcnt(0)" ::: "memory")
__device__ __forceinline__ unsigned f2bf(float f) { unsigned u = __builtin_bit_cast(unsigned, f); return (u + 0x7fffu + ((u >> 16) & 1u)) >> 16; }
__device__ __forceinline__ unsigned pk2(float lo, float hi) { return f2bf(lo) | (f2bf(hi) << 16); }
__device__ __forceinline__ float bf2f(unsigned h) { return __builtin_bit_cast(float, h << 16); }
__device__ __forceinline__ float wave_sum(float v) {
#pragma unroll
    for (int o = 1; o < 64; o <<= 1) v += __shfl_xor(v, o);
    return v;
}
__device__ __forceinline__ int p16(int k) { return ((k >> 2) & 1) * 8 + (k >> 3) * 4 + (k & 3); }
__device__ __forceinline__ float sigmoidf_(float v) { return __builtin_amdgcn_rcpf(1.f + __builtin_amdgcn_exp2f(-v * LOG2E)); }
__device__ __forceinline__ v2u pack4(f32x4 v) { v2u r; r.x = cvt_pk_bf16(v[0], v[1]); r.y = cvt_pk_bf16(v[2], v[3]); return r; }
__device__ __forceinline__ v4u pack8(f32x4 a, f32x4 b) { v4u r; r.x = cvt_pk_bf16(a[0], a[1]); r.y = cvt_pk_bf16(a[2], a[3]); r.z = cvt_pk_bf16(b[0], b[1]); r.w = cvt_pk_bf16(b[2], b[3]); return r; }

using pg8::Unit;
struct EpiInProj {
    static constexpr bool PERM = true, AFTER_DRAIN = false;
    bf16 *Qd, *Kd, *VdT, *GATES, *QL, *KVL, *Km; const float *bgate, *tdc, *tds, *tmc, *tms; float *ssq, *sskv;
    __device__ __forceinline__ void operator()(const f32x4 (&acc)[2][2][4][2], const Unit& u, int wr, int wc, int fr, int fq) const {
        const int pn = u.pn; const int row0 = u.pm * 256 + wr * 64 + fr;
        if (pn < 4) {
            bf16* dst = pn < 2 ? Qd : Kd; const float sc = pn < 2 ? QS_D : 1.f; const int cb = (pn & 1) * 256 + wc * 32 + 8 * fq;
            const bool rope = (wc & 1) == 0;
#pragma unroll
            for (int ai = 0; ai < 2; ++ai)
#pragma unroll
                for (int m = 0; m < 4; ++m) {
                    const int row = row0 + ai * 128 + m * 16;
                    f32x4 c0 = {1.f, 1.f, 1.f, 1.f}, c1 = c0, s0 = {0.f, 0.f, 0.f, 0.f}, s1 = s0;
                    if (rope) { c0 = *(const f32x4*)(tdc + (size_t)row * 8); c1 = *(const f32x4*)(tdc + (size_t)row * 8 + 4); s0 = *(const f32x4*)(tds + (size_t)row * 8); s1 = *(const f32x4*)(tds + (size_t)row * 8 + 4); }
#pragma unroll
                    for (int bj = 0; bj < 2; ++bj) {
                        f32x4 v0 = acc[ai][bj][m][0], v1 = acc[ai][bj][m][1];
                        if (rope) {
#pragma unroll
                            for (int j = 0; j < 4; ++j) {
                                const float p0 = __shfl_xor(v0[j], 16), p1 = __shfl_xor(v1[j], 16);
                                if (fq == 0) { v0[j] = v0[j] * c0[j] - p0 * s0[j]; v1[j] = v1[j] * c1[j] - p1 * s1[j]; }
                                else if (fq == 1) { v0[j] = v0[j] * c0[j] + p0 * s0[j]; v1[j] = v1[j] * c1[j] + p1 * s1[j]; }
                            }
                        }
                        v0 = v0 * sc; v1 = v1 * sc;
                        *(v4u*)(dst + (size_t)row * 512 + cb + bj * 128) = pack8(v0, v1);
                    }
                }
        } else if (pn < 6) {
#pragma unroll
            for (int ai = 0; ai < 2; ++ai)
#pragma unroll
                for (int m = 0; m < 4; ++m) {
                    const int row = row0 + ai * 128 + m * 16; const int b = row >> 13, pos = row & (SEQ - 1), pp = (pos & ~15) | p16(pos & 15);
#pragma unroll
                    for (int bj = 0; bj < 2; ++bj) {
                        const int h = (pn - 4) * 2 + bj;
                        bf16* base = VdT + ((size_t)((b * 4 + h) * 128 + wc * 32 + 8 * fq)) * SEQ + pp;
#pragma unroll
                        for (int n = 0; n < 2; ++n)
#pragma unroll
                            for (int j = 0; j < 4; ++j) base[(size_t)(4 * n + j) * SEQ] = (bf16)f2bf(acc[ai][bj][m][n][j]);
                    }
                }
        } else if (pn < 14) {
            const int cb = (pn - 6) * 256 + wc * 32 + 8 * fq;
            f32x4 bv[2][2];
#pragma unroll
            for (int bj = 0; bj < 2; ++bj) { bv[bj][0] = *(const f32x4*)(bgate + cb + bj * 128); bv[bj][1] = *(const f32x4*)(bgate + cb + bj * 128 + 4); }
#pragma unroll
            for (int ai = 0; ai < 2; ++ai)
#pragma unroll
                for (int m = 0; m < 4; ++m) {
                    const int row = row0 + ai * 128 + m * 16;
#pragma unroll
                    for (int bj = 0; bj < 2; ++bj) {
                        f32x4 v0 = acc[ai][bj][m][0] + bv[bj][0], v1 = acc[ai][bj][m][1] + bv[bj][1];
#pragma unroll
                        for (int j = 0; j < 4; ++j) { v0[j] = sigmoidf_(v0[j]); v1[j] = sigmoidf_(v1[j]); }
                        *(v4u*)(GATES + (size_t)row * 2048 + cb + bj * 128) = pack8(v0, v1);
                    }
                }
        } else {
#pragma unroll
            for (int bj = 0; bj < 2; ++bj) {
                const int hh = 2 * (pn - 14) + bj;
                if (hh <= 4) {
                    bf16* dst; int ld, cb; float* ss; int sld;
                    if (hh <= 2) { dst = QL; ld = 384; cb = hh * 128; ss = ssq + hh * 4 + wc; sld = 16; } else { dst = KVL; ld = 256; cb = (hh - 3) * 128; ss = sskv + (hh - 3) * 4 + wc; sld = 8; }
                    cb += wc * 32 + 8 * fq;
#pragma unroll
                    for (int ai = 0; ai < 2; ++ai)
#pragma unroll
                        for (int m = 0; m < 4; ++m) {
                            const int row = row0 + ai * 128 + m * 16;
                            const f32x4 v0 = acc[ai][bj][m][0], v1 = acc[ai][bj][m][1];
                            float s = (v0[0] * v0[0] + v0[1] * v0[1]) + (v0[2] * v0[2] + v0[3] * v0[3]) + (v1[0] * v1[0] + v1[1] * v1[1]) + (v1[2] * v1[2] + v1[3] * v1[3]);
                            s += __shfl_xor(s, 16); s += __shfl_xor(s, 32);
                            if (fq == 0) ss[(size_t)row * sld] = s;
                            *(v4u*)(dst + (size_t)row * ld + cb) = pack8(v0, v1);
                        }
                } else if (wc == 0) {
#pragma unroll
                    for (int ai = 0; ai < 2; ++ai)
#pragma unroll
                        for (int m = 0; m < 4; ++m) {
                            const int row = row0 + ai * 128 + m * 16;
                            const f32x4 c0 = *(const f32x4*)(tmc + (size_t)row * 16 + 8 * (fq & 1)), c1 = *(const f32x4*)(tmc + (size_t)row * 16 + 8 * (fq & 1) + 4);
                            const f32x4 s0 = *(const f32x4*)(tms + (size_t)row * 16 + 8 * (fq & 1)), s1 = *(const f32x4*)(tms + (size_t)row * 16 + 8 * (fq & 1) + 4);
                            f32x4 v0 = acc[ai][bj][m][0], v1 = acc[ai][bj][m][1];
#pragma unroll
                            for (int j = 0; j < 4; ++j) {
                                const float p0 = __shfl_xor(v0[j], 32), p1 = __shfl_xor(v1[j], 32);
                                if (fq < 2) { v0[j] = v0[j] * c0[j] - p0 * s0[j]; v1[j] = v1[j] * c1[j] - p1 * s1[j]; }
                                else { v0[j] = v0[j] * c0[j] + p0 * s0[j]; v1[j] = v1[j] * c1[j] + p1 * s1[j]; }
                            }
                            const v4u w = pack8(v0, v1);
#pragma unroll
                            for (int h = 0; h < 8; ++h) *(v4u*)(Km + (size_t)row * 768 + h * 96 + 64 + 8 * fq) = w;
                        }
                }
            }
        }
    }
};
struct EpiQup {
    static constexpr bool PERM = false, AFTER_DRAIN = false;
    bf16* Qm; const float *ssq, *tmc, *tms;
    __device__ __forceinline__ void operator()(const f32x4 (&acc)[2][2][4][2], const Unit& u, int wr, int wc, int fr, int fq) const {
        const int row0 = u.pm * 256 + wr * 64 + fr;
#pragma unroll
        for (int ai = 0; ai < 2; ++ai)
#pragma unroll
            for (int m = 0; m < 4; ++m) {
                const int row = row0 + ai * 128 + m * 16;
                const f32x4 pa = *(const f32x4*)(ssq + (size_t)row * 16), pb = *(const f32x4*)(ssq + (size_t)row * 16 + 4), pc = *(const f32x4*)(ssq + (size_t)row * 16 + 8);
                const float sq = ((pa[0] + pa[1]) + (pa[2] + pa[3])) + ((pb[0] + pb[1]) + (pb[2] + pb[3])) + ((pc[0] + pc[1]) + (pc[2] + pc[3]));
                const float rs = rsqrtf(sq * (1.f / 384.f) + EPS) * QS_M;
#pragma unroll
                for (int bj = 0; bj < 2; ++bj) {
                    const int gi = 8 * u.pn + 4 * bj + wc, part = gi % 3;
                    f32x4 v0 = acc[ai][bj][m][0] * rs, v1 = acc[ai][bj][m][1] * rs;
                    if (part == 2) {
                        const f32x4 c = *(const f32x4*)(tmc + (size_t)row * 16 + 4 * fq), s = *(const f32x4*)(tms + (size_t)row * 16 + 4 * fq);
                        const f32x4 o0 = v0 * c - v1 * s, o1 = v1 * c + v0 * s; v0 = o0; v1 = o1;
                    }
                    bf16* p = Qm + (size_t)row * 768 + 32 * gi + 4 * fq;
                    *(v2u*)p = pack4(v0); *(v2u*)(p + 16) = pack4(v1);
                }
                asm volatile("" ::: "memory");
            }
    }
};
struct EpiKVup {
    static constexpr bool PERM = false, AFTER_DRAIN = false;
    bf16 *Km, *VmT; const float* sskv;
    __device__ __forceinline__ void operator()(const f32x4 (&acc)[2][2][4][2], const Unit& u, int wr, int wc, int fr, int fq) const {
        const int row0 = u.pm * 256 + wr * 64 + fr;
#pragma unroll
        for (int ai = 0; ai < 2; ++ai)
#pragma unroll
            for (int m = 0; m < 4; ++m) {
                const int row = row0 + ai * 128 + m * 16; const int b = row >> 13, pos = row & (SEQ - 1), pp = (pos & ~15) | p16(pos & 15);
                const f32x4 pa = *(const f32x4*)(sskv + (size_t)row * 8), pb = *(const f32x4*)(sskv + (size_t)row * 8 + 4);
                const float rs = rsqrtf((((pa[0] + pa[1]) + (pa[2] + pa[3])) + ((pb[0] + pb[1]) + (pb[2] + pb[3]))) * (1.f / 256.f) + EPS);
#pragma unroll
                for (int bj = 0; bj < 2; ++bj) {
                    const int head = 2 * u.pn + bj;
                    const f32x4 v0 = acc[ai][bj][m][0] * rs, v1 = acc[ai][bj][m][1] * rs;
                    if (wc < 2) {
                        bf16* p = Km + (size_t)row * 768 + head * 96 + 32 * wc + 4 * fq;
                        *(v2u*)p = pack4(v0); *(v2u*)(p + 16) = pack4(v1);
                    } else {
                        bf16* base = VmT + ((size_t)((b * 8 + head) * 64 + 32 * (wc - 2) + 4 * fq)) * SEQ + pp;
#pragma unroll
                        for (int j = 0; j < 4; ++j) { base[(size_t)j * SEQ] = (bf16)f2bf(v0[j]); base[(size_t)(16 + j) * SEQ] = (bf16)f2bf(v1[j]); }
                    }
                }
                asm volatile("" ::: "memory");
            }
    }
};
template <int STEP> struct EpiBranch {
    static constexpr bool PERM = false, AFTER_DRAIN = false;
    const bf16* GATES; float* TMP; bf16* MERGED;
    __device__ __forceinline__ void operator()(const f32x4 (&acc)[2][2][4][2], const Unit& u, int wr, int wc, int fr, int fq) const {
        const int row0 = u.pm * 256 + wr * 64 + fr, col0 = u.pn * 256 + wc * 32 + 4 * fq;
#pragma unroll
        for (int ai = 0; ai < 2; ++ai)
#pragma unroll
            for (int m = 0; m < 4; ++m) {
                const int row = row0 + ai * 128 + m * 16;
#pragma unroll
                for (int bj = 0; bj < 2; ++bj)
#pragma unroll
                    for (int n = 0; n < 2; ++n) {
                        const int col = col0 + bj * 128 + n * 16;
                        const v2u gw = *(const v2u*)(GATES + (size_t)row * 2048 + STEP * 1024 + col);
                        const f32x4 g = {bf2f(gw.x & 0xffffu), bf2f(gw.x >> 16), bf2f(gw.y & 0xffffu), bf2f(gw.y >> 16)};
                        float* tp = TMP + (size_t)row * 1024 + col;
                        if (STEP == 0) *(f32x4*)tp = acc[ai][bj][m][n] * g;
                        else { const f32x4 t = *(const f32x4*)tp; *(v2u*)(MERGED + (size_t)row * 1024 + col) = pack4(t + acc[ai][bj][m][n] * g); }
                    }
            }
    }
};
struct EpiRes {
    static constexpr bool PERM = false, AFTER_DRAIN = false;
    const float* base; float* out; bf16* outb; float* ss;
    __device__ __forceinline__ void operator()(const f32x4 (&acc)[2][2][4][2], const Unit& u, int wr, int wc, int fr, int fq) const {
        const int row0 = u.pm * 256 + wr * 64 + fr, col0 = u.pn * 256 + wc * 32 + 4 * fq;
#pragma unroll
        for (int ai = 0; ai < 2; ++ai)
#pragma unroll
            for (int m = 0; m < 4; ++m) {
                const int row = row0 + ai * 128 + m * 16; float s = 0.f;
#pragma unroll
                for (int bj = 0; bj < 2; ++bj)
#pragma unroll
                    for (int n = 0; n < 2; ++n) {
                        const size_t off = (size_t)row * 1024 + col0 + bj * 128 + n * 16;
                        const f32x4 v = *(const f32x4*)(base + off) + acc[ai][bj][m][n];
                        s += (v[0] * v[0] + v[1] * v[1]) + (v[2] * v[2] + v[3] * v[3]);
                        *(f32x4*)(out + off) = v;
                        if (outb) *(v2u*)(outb + off) = pack4(v);
                    }
                s += __shfl_xor(s, 16); s += __shfl_xor(s, 32);
                if (fq == 0) ss[(size_t)row * 16 + u.pn * 4 + wc] = s;
            }
    }
};
struct EpiSwiglu {
    static constexpr bool PERM = true, AFTER_DRAIN = false;
    bf16* H; const float* ss1;
    __device__ __forceinline__ void operator()(const f32x4 (&acc)[2][2][4][2], const Unit& u, int wr, int wc, int fr, int fq) const {
        const int row0 = u.pm * 256 + wr * 64 + fr, col0 = u.pn * 128 + wc * 32 + 8 * fq;
#pragma unroll
        for (int ai = 0; ai < 2; ++ai)
#pragma unroll
            for (int m = 0; m < 4; ++m) {
                const int row = row0 + ai * 128 + m * 16;
                float sq = 0.f;
#pragma unroll
                for (int k = 0; k < 4; ++k) { const f32x4 p = *(const f32x4*)(ss1 + (size_t)row * 16 + 4 * k); sq += (p[0] + p[1]) + (p[2] + p[3]); }
                const float rs = rsqrtf(sq * (1.f / 1024.f) + EPS);
                f32x4 o[2];
#pragma unroll
                for (int n = 0; n < 2; ++n) {
                    const f32x4 g = acc[ai][0][m][n] * rs, up = acc[ai][1][m][n] * rs;
#pragma unroll
                    for (int j = 0; j < 4; ++j) o[n][j] = g[j] * sigmoidf_(g[j]) * up[j];
                }
                *(v4u*)(H + (size_t)row * FF + col0) = pack8(o[0], o[1]);
            }
    }
};

template <int DK, int DV>
__device__ __forceinline__ void attn_unit(LAS unsigned char* lds, const bf16* Qp, int ldq, const bf16* Kp, int ldk, const bf16* VTp, bf16* Op, int ldo, int qb) {
    constexpr int KC = DK / 8, KP = DK * 2 + 16, VP = 144, KTB = 64 * KP, BUF = KTB + DV * VP;
    constexpr int KCH = 64 * KC, VCH = DV * 8, NKL = (KCH + 511) / 512, NVL = VCH / 512, NDB = DV / 32;
    const int tid = threadIdx.x, lane = tid & 63, w = __builtin_amdgcn_readfirstlane(tid >> 6), q = lane & 31, hi = lane >> 5;
    const int q0 = qb * 256, NT = 4 * (qb + 1);
    bf16x8 qf[DK / 16];
    { const bf16* qrow = Qp + (size_t)(q0 + 32 * w + q) * ldq + 8 * hi;
#pragma unroll
      for (int c = 0; c < DK / 16; ++c) qf[c] = *(const bf16x8*)(qrow + 16 * c); }
    v4u kreg[NKL], vreg[NVL];
#define ATT_LOAD(t) do { \
    _Pragma("unroll") for (int i_ = 0; i_ < NKL; ++i_) { const int id_ = tid + 512 * i_; if ((KCH % 512 == 0) || id_ < KCH) { const int r_ = id_ / KC, c_ = id_ % KC; kreg[i_] = *(const v4u*)(Kp + (size_t)(64 * (t) + r_) * ldk + c_ * 8); } } \
    _Pragma("unroll") for (int i_ = 0; i_ < NVL; ++i_) { const int id_ = tid + 512 * i_; const int d_ = id_ >> 3, c_ = id_ & 7; vreg[i_] = *(const v4u*)(VTp + (size_t)d_ * SEQ + 64 * (t) + c_ * 8); } } while (0)
#define ATT_STORE(buf) do { \
    _Pragma("unroll") for (int i_ = 0; i_ < NKL; ++i_) { const int id_ = tid + 512 * i_; if ((KCH % 512 == 0) || id_ < KCH) { const int r_ = id_ / KC, c_ = id_ % KC; *(LAS v4u*)(lds + (buf) * BUF + r_ * KP + c_ * 16) = kreg[i_]; } } \
    _Pragma("unroll") for (int i_ = 0; i_ < NVL; ++i_) { const int id_ = tid + 512 * i_; const int d_ = id_ >> 3, c_ = id_ & 7; *(LAS v4u*)(lds + (buf) * BUF + KTB + d_ * VP + c_ * 16) = vreg[i_]; } } while (0)
    ATT_LOAD(0); ATT_STORE(0);
    __syncthreads();
    float mrun = -1e30f, lrun = 0.f;
    f32x16 o[NDB];
#pragma unroll
    for (int db = 0; db < NDB; ++db)
#pragma unroll
        for (int r = 0; r < 16; ++r) o[db][r] = 0.f;
    for (int t = 0; t < NT; ++t) {
        const int buf = t & 1;
        if (t + 1 < NT) ATT_LOAD(t + 1);
        const int tb = t - (NT - 4);
        if (tb < 0 || 64 * tb <= 32 * w + 31) {
            const LAS unsigned char* kb_ = lds + buf * BUF + q * KP + hi * 16;
            f32x16 s0, s1;
#pragma unroll
            for (int r = 0; r < 16; ++r) { s0[r] = 0.f; s1[r] = 0.f; }
#pragma unroll
            for (int c = 0; c < DK / 16; ++c) {
                const bf16x8 a0 = *(const LAS bf16x8*)(kb_ + c * 32), a1 = *(const LAS bf16x8*)(kb_ + 32 * KP + c * 32);
                s0 = __builtin_amdgcn_mfma_f32_32x32x16_bf16(a0, qf[c], s0, 0, 0, 0);
                s1 = __builtin_amdgcn_mfma_f32_32x32x16_bf16(a1, qf[c], s1, 0, 0, 0);
            }
            if (tb >= 0) {
                const int qrel = 32 * w + q, kb0 = 64 * tb + 4 * hi;
#pragma unroll
                for (int r = 0; r < 16; ++r) { const int kv = kb0 + (r & 3) + 8 * (r >> 2); if (kv > qrel) s0[r] = -INFINITY; if (kv + 32 > qrel) s1[r] = -INFINITY; }
            }
            float mx = fmaxf(s0[0], s1[0]);
#pragma unroll
            for (int r = 1; r < 16; ++r) mx = fmaxf(mx, fmaxf(s0[r], s1[r]));
            mx = fmaxf(mx, __shfl_xor(mx, 32));
            const float mn = fmaxf(mrun, mx), alpha = __builtin_amdgcn_exp2f(mrun - mn); mrun = mn;
            float ps = 0.f;
#pragma unroll
            for (int r = 0; r < 16; ++r) { s0[r] = __builtin_amdgcn_exp2f(s0[r] - mn); s1[r] = __builtin_amdgcn_exp2f(s1[r] - mn); ps += s0[r] + s1[r]; }
            lrun = lrun * alpha + ps;
#pragma unroll
            for (int db = 0; db < NDB; ++db)
#pragma unroll
                for (int r = 0; r < 16; ++r) o[db][r] *= alpha;
            const LAS unsigned char* vb_ = lds + buf * BUF + KTB + q * VP + hi * 16;
#pragma unroll
            for (int c4 = 0; c4 < 4; ++c4) {
                v4u pw; const int b8 = 8 * (c4 & 1);
                if (c4 < 2) { pw.x = cvt_pk_bf16(s0[b8 + 0], s0[b8 + 1]); pw.y = cvt_pk_bf16(s0[b8 + 2], s0[b8 + 3]); pw.z = cvt_pk_bf16(s0[b8 + 4], s0[b8 + 5]); pw.w = cvt_pk_bf16(s0[b8 + 6], s0[b8 + 7]); }
                else        { pw.x = cvt_pk_bf16(s1[b8 + 0], s1[b8 + 1]); pw.y = cvt_pk_bf16(s1[b8 + 2], s1[b8 + 3]); pw.z = cvt_pk_bf16(s1[b8 + 4], s1[b8 + 5]); pw.w = cvt_pk_bf16(s1[b8 + 6], s1[b8 + 7]); }
                const bf16x8 pb = __builtin_bit_cast(bf16x8, pw);
#pragma unroll
                for (int db = 0; db < NDB; ++db) {
                    const bf16x8 va = *(const LAS bf16x8*)(vb_ + db * 32 * VP + c4 * 32);
                    o[db] = __builtin_amdgcn_mfma_f32_32x32x16_bf16(va, pb, o[db], 0, 0, 0);
                }
            }
        }
        if (t + 1 < NT) ATT_STORE(buf ^ 1);
        __syncthreads();
    }
#undef ATT_LOAD
#undef ATT_STORE
    lrun += __shfl_xor(lrun, 32);
    const float inv = 1.f / lrun;
    bf16* orow = Op + (size_t)(q0 + 32 * w + q) * ldo + 4 * hi;
#pragma unroll
    for (int db = 0; db < NDB; ++db)
#pragma unroll
        for (int g = 0; g < 4; ++g) {
            const f32x4 v = {o[db][4 * g] * inv, o[db][4 * g + 1] * inv, o[db][4 * g + 2] * inv, o[db][4 * g + 3] * inv};
            *(v2u*)(orow + 32 * db + 8 * g) = pack4(v);
        }
}

__device__ __forceinline__ void tr_item(const float* W, int Nsrc, int src0, const float* g, bf16* WT, int Kdim, int dst_row0, int k0, LAS float* scr, int lane) {
#pragma unroll 8
    for (int i = 0; i < 32; ++i) { const int kk = 2 * i + (lane >> 5); float v = 0.f; if (src0 >= 0) { v = W[(size_t)(k0 + kk) * Nsrc + src0 + (lane & 31)]; if (g) v *= g[k0 + kk]; } scr[kk * 33 + (lane & 31)] = v; }
    LDS_WAIT(); asm volatile("" ::: "memory");
    const int c = lane & 7;
#pragma unroll
    for (int j = 0; j < 4; ++j) { const int n = (lane >> 3) + 8 * j; const LAS float* s = scr + (8 * c) * 33 + n;
        v4u o; o.x = pk2(s[0 * 33], s[1 * 33]); o.y = pk2(s[2 * 33], s[3 * 33]); o.z = pk2(s[4 * 33], s[5 * 33]); o.w = pk2(s[6 * 33], s[7 * 33]);
        *(v4u*)(WT + (size_t)(dst_row0 + n) * Kdim + k0 + 8 * c) = o; }
    LDS_WAIT(); asm volatile("" ::: "memory");
}
__device__ __forceinline__ int inproj_src(int pc) {
    if (pc < 512) return 672 + pc;
    if (pc < 1024) return 1184 + (pc - 512);
    if (pc < 1536) return 1696 + (pc - 1024);
    if (pc < 3584) return 2208 + (pc - 1536);
    if (pc < 3968) return pc - 3584;
    if (pc < 4224) return 384 + (pc - 3968);
    if (pc < 4256) return 640 + (pc - 4224);
    return -1;
}

typedef unsigned v4u_xb __attribute__((ext_vector_type(4)));
#define XB_TMO      128
#define XB_XCNT(j)  (256  + 64 * (j))
#define XB_XSUB(j)  (1280 + 64 * (j))
#define XB_XGEN(j)  (2304 + 64 * (j))
#define XB_TOP      3328
#define XB_TOPGEN   3392
#define XCD_BAR_WORDS 3456
#define XB_SPIN_CAP (1u << 18)

__device__ __forceinline__ unsigned xb_ld(unsigned* p)              { return __hip_atomic_load(p, __ATOMIC_RELAXED, __HIP_MEMORY_SCOPE_AGENT); }
__device__ __forceinline__ unsigned xb_add(unsigned* p, unsigned v) { return __hip_atomic_fetch_add(p, v, __ATOMIC_RELAXED, __HIP_MEMORY_SCOPE_AGENT); }
__device__ __forceinline__ unsigned xb_xcc_id() { return (unsigned)__builtin_amdgcn_s_getreg((3 << 11) | 20) & 0xFu; }
#define XB_SPIN(cond, bar) do { unsigned _sp = 0; while (cond) { __builtin_amdgcn_s_sleep(1); \
    if ((++_sp & 255u) == 0u) { if (xb_ld(&(bar)[XB_TMO])) break; if (_sp > XB_SPIN_CAP) { atomicAdd(&(bar)[XB_TMO], 1u); break; } } } } while (0)

struct XcdBarrier {
    unsigned* bar; unsigned x;
    volatile LAS unsigned* st;
};

__device__ __forceinline__ XcdBarrier xcd_barrier_post(unsigned* bar, volatile LAS unsigned* st) {
    XcdBarrier b; b.bar = bar; b.x = xb_xcc_id(); b.st = st;
    if (threadIdx.x == 0) (void)xb_add(&bar[XB_XCNT(b.x)], 1u);
    return b;
}
__device__ __forceinline__ void xcd_barrier_complete(unsigned* bar, unsigned x, unsigned& nloc, unsigned& nx) {
    const unsigned G = gridDim.x * gridDim.y * gridDim.z;
    unsigned sum, cnt, mine, sp = 0u;
    for (;;) {
        sum = 0u; cnt = 0u; mine = 0u;
#pragma unroll
        for (unsigned j = 0; j < 16; ++j) { const unsigned c = xb_ld(&bar[XB_XCNT(j)]); sum += c; cnt += (c > 0u) ? 1u : 0u; mine = (j == x) ? c : mine; }
        if (sum == G) break;
        __builtin_amdgcn_s_sleep(1);
        if ((++sp & 255u) == 0u) { if (xb_ld(&bar[XB_TMO])) break; if (sp > XB_SPIN_CAP) { atomicAdd(&bar[XB_TMO], 1u); break; } }
    }
    nloc = mine > 0u ? mine : 1u; nx = cnt > 0u ? cnt : 1u;
}

__device__ __forceinline__ void xcd_barrier(const XcdBarrier& b) {
    asm volatile("s_waitcnt vmcnt(0)" ::: "memory");
    __syncthreads();
    if (threadIdx.x == 0) {
        unsigned* bar = b.bar;
        __builtin_amdgcn_s_waitcnt(0);
        unsigned nloc = b.st[0], nx = b.st[1];
        if (nloc == 0u) { xcd_barrier_complete(bar, b.x, nloc, nx); b.st[0] = nloc; b.st[1] = nx; }
        const unsigned old = xb_add(&bar[XB_XSUB(b.x)], 1u);
        const unsigned gen = old / nloc;
        if (old + 1u == (gen + 1u) * nloc) {
            __builtin_amdgcn_fence(__ATOMIC_RELEASE, "agent");
            asm volatile("s_waitcnt vmcnt(0)" ::: "memory");
            const unsigned og = xb_add(&bar[XB_TOP], 1u);
            const unsigned tg = og / nx;
            if (og + 1u == (tg + 1u) * nx) xb_add(&bar[XB_TOPGEN], 1u);
            else XB_SPIN(xb_ld(&bar[XB_TOPGEN]) == tg, bar);
            __builtin_amdgcn_fence(__ATOMIC_ACQUIRE, "agent");
            xb_add(&bar[XB_XGEN(b.x)], 1u);
            asm volatile("s_waitcnt vmcnt(0)" ::: "memory");
        } else {
            XB_SPIN(xb_ld(&bar[XB_XGEN(b.x)]) == gen, bar);
            __builtin_amdgcn_fence(__ATOMIC_ACQUIRE, "agent");
            asm volatile("s_waitcnt vmcnt(0)" ::: "memory");
        }
    }
    __syncthreads();
}

#define GRID_SYNC() xcd_barrier(xbar)
struct Args {
    const float* x; const int* positions; const float *norm_mix_g, *w_in, *b_gate, *mla_q_norm_g, *mla_w_uq, *mla_kv_norm_g, *mla_w_ukv;
    const float *lq1, *lk1, *lq2, *lk2, *subln_g, *w_branch_mla, *w_branch_diff, *w_out, *norm_ffn_g, *w_ffn_gate, *w_ffn_up, *w_ffn_down, *norm_final_g;
    float* out; unsigned char* ws;
};

__global__ void __launch_bounds__(512, 2) fwd_megakernel(Args a) {
    extern __shared__ __attribute__((aligned(16))) unsigned char lds_raw[];
    LAS unsigned char* lds = (LAS unsigned char*)lds_raw;
    cg::grid_group grid = cg::this_grid();
    const int tid = threadIdx.x, lane = tid & 63, wave = __builtin_amdgcn_readfirstlane(tid >> 6);
    const int G = gridDim.x, bx = blockIdx.x;
    const int vcu = (G % 8 == 0) ? (bx % 8) * (G / 8) + bx / 8 : bx;
    const int gw = vcu * 8 + wave, NGW = G * 8;
    unsigned char* ws = a.ws;
    for (int u_ = tid; u_ < 64; u_ += 512) ((LAS unsigned*)(lds + 131072))[u_] = 0u;
    __syncthreads();
    grid.sync();
    XcdBarrier xbar = xcd_barrier_post((unsigned*)(ws + WS_SS) + 4096, (volatile LAS unsigned*)(lds + 131072 + 32));
    float* ssq = (float*)(ws + WS_PART); float* sskv = ssq + (size_t)M * 16; float* ss1 = sskv + (size_t)M * 16; float* ss2 = ss1 + (size_t)M * 16;
    float* tdc = (float*)(ws + WS_TAB); float* tds = tdc + (size_t)M * 8; float* tmc = tds + (size_t)M * 8; float* tms = tmc + (size_t)M * 16;
    bf16 *W1 = (bf16*)(ws + WS_W1), *W2A = (bf16*)(ws + WS_W2A), *W2B = (bf16*)(ws + WS_W2B), *W3A = (bf16*)(ws + WS_W3A), *W3B = (bf16*)(ws + WS_W3B), *W4 = (bf16*)(ws + WS_W4), *W5 = (bf16*)(ws + WS_W5), *W6 = (bf16*)(ws + WS_W6);
    bf16 *XN = (bf16*)(ws + WS_XN), *QL = (bf16*)(ws + WS_QL), *KVL = (bf16*)(ws + WS_KVL), *OM = (bf16*)(ws + WS_OM), *ODR = (bf16*)(ws + WS_ODR);
    bf16 *QD = (bf16*)(ws + WS_QD), *ODN = (bf16*)(ws + WS_ODN), *KD = (bf16*)(ws + WS_KD), *VDT = (bf16*)(ws + WS_VDT), *MERGED = (bf16*)(ws + WS_MERGED);
    bf16 *QM = (bf16*)(ws + WS_QM), *KM = (bf16*)(ws + WS_KM), *VMT = (bf16*)(ws + WS_VMT), *X1B = (bf16*)(ws + WS_X1B), *HB = (bf16*)(ws + WS_H);
    float* TMP = (float*)(ws + WS_TMP);
    bf16* GATES = (bf16*)a.out;

    if (PH(0)) {
        LAS float* scr = (LAS float*)(lds + wave * 16384);
        constexpr int I1 = 16 * (N1 / 32), I2A = 6 * 24, I2B = 4 * 32, I3 = 8 * 32, I4 = 16 * 32, I5 = 16 * (2 * FF / 32), I6 = (FF / 64) * 32;
        constexpr int NITEMS = I1 + I2A + I2B + 2 * I3 + I4 + I5 + I6;
        for (int it = gw; it < NITEMS; it += NGW) {
            int r = it;
            if (r < I1) { const int nb = r % (N1 / 32), kb = r / (N1 / 32); tr_item(a.w_in, 4256, inproj_src(32 * nb), nullptr, W1, 1024, 32 * nb, 64 * kb, scr, lane); continue; } r -= I1;
            if (r < I2A) { const int nb = r % 24, kb = r / 24; tr_item(a.mla_w_uq, 768, 32 * nb, a.mla_q_norm_g, W2A, 384, 32 * nb, 64 * kb, scr, lane); continue; } r -= I2A;
            if (r < I2B) { const int nb = r % 32, kb = r / 32; tr_item(a.mla_w_ukv, 1024, 32 * nb, a.mla_kv_norm_g, W2B, 256, 32 * nb, 64 * kb, scr, lane); continue; } r -= I2B;
            if (r < I3) { const int nb = r % 32, kb = r / 32; tr_item(a.w_branch_mla, 1024, 32 * nb, nullptr, W3A, 512, 32 * nb, 64 * kb, scr, lane); continue; } r -= I3;
            if (r < I3) { const int nb = r % 32, kb = r / 32; tr_item(a.w_branch_diff, 1024, 32 * nb, nullptr, W3B, 512, 32 * nb, 64 * kb, scr, lane); continue; } r -= I3;
            if (r < I4) { const int nb = r % 32, kb = r / 32; tr_item(a.w_out, 1024, 32 * nb, nullptr, W4, 1024, 32 * nb, 64 * kb, scr, lane); continue; } r -= I4;
            if (r < I5) { const int nb = r % (2 * FF / 32), kb = r / (2 * FF / 32); const int pc = 32 * nb, tile = pc >> 8, inner = pc & 255;
                const float* W = inner < 128 ? a.w_ffn_gate : a.w_ffn_up; tr_item(W, FF, 128 * tile + (inner & 127), a.norm_ffn_g, W5, 1024, pc, 64 * kb, scr, lane); continue; } r -= I5;
            { const int nb = r % 32, kb = r / 32; tr_item(a.w_ffn_down, 1024, 32 * nb, nullptr, W6, FF, 32 * nb, 64 * kb, scr, lane); }
        }
        for (int m = gw; m < M; m += NGW) {
            const f32x4* xr = (const f32x4*)(a.x + (size_t)m * D) + lane; const f32x4* gr = (const f32x4*)a.norm_mix_g + lane;
            f32x4 v[4]; float s = 0.f;
#pragma unroll
            for (int j = 0; j < 4; ++j) { v[j] = xr[64 * j]; s += (v[j][0] * v[j][0] + v[j][1] * v[j][1]) + (v[j][2] * v[j][2] + v[j][3] * v[j][3]); }
            const float rs = rsqrtf(wave_sum(s) * (1.f / D) + EPS);
            v2u* o8 = (v2u*)(XN + (size_t)m * D) + lane;
#pragma unroll
            for (int j = 0; j < 4; ++j) o8[64 * j] = pack4(v[j] * rs * gr[64 * j]);
        }
        const int gt = vcu * 512 + tid, NGT = G * 512;
        for (int i = gt; i < M * 24; i += NGT) {
            const int tok = i / 24, f = i % 24; const float pos = (float)a.positions[tok];
            const bool dm = f >= 8; const int fi = dm ? f - 8 : f;
            const float inv = expf((-13.122363377404328f * (float)fi) * (dm ? (2.0f / 32.0f) : (2.0f / 16.0f)));
            const float ang = pos * inv;
            const double ad = (double)ang, kd = rint(ad * 0.15915494309189535), rd = ad - kd * 6.283185307179586;
            const float rr = (float)rd, cs = __cosf(rr), sn = __sinf(rr);
            if (dm) { tmc[(size_t)tok * 16 + fi] = cs; tms[(size_t)tok * 16 + fi] = sn; } else { tdc[(size_t)tok * 8 + fi] = cs; tds[(size_t)tok * 8 + fi] = sn; }
        }
    }
    GRID_SYNC();

    if (PH(1)) {
        pg8::Gemm g{XN, W1, M, N1, D}; pg8::StaticOrder S; S.init(M, N1, G, bx);
        EpiInProj E{QD, KD, VDT, GATES, QL, KVL, KM, a.b_gate, tdc, tds, tmc, tms, ssq, sskv};
        pg8::gemm_phase<EpiInProj, pg8::StaticOrder, true, true>(lds, g, S, E);
    }
    GRID_SYNC();

    if (PH(2)) {
        pg8::Gemm g{KVL, W2B, M, 1024, 256}; pg8::StaticOrder S; S.init(M, 1024, G, bx);
        EpiKVup E{KM, VMT, sskv};
        pg8::gemm_phase<EpiKVup, pg8::StaticOrder, true, true>(lds, g, S, E);
    }
    __syncthreads();
    if (PH(3)) {
        pg8::Gemm g{QL, W2A, M, 768, 384}; pg8::StaticOrder S; S.init(M, 768, G, bx);
        EpiQup E{QM, ssq, tmc, tms};
        pg8::gemm_phase<EpiQup, pg8::StaticOrder, true, true>(lds, g, S, E);
    }
    GRID_SYNC();

    if (PH(4)) for (int j = vcu; j < 1024; j += G) {
        const int i = j >> 8, v = j & 255, bh = v >> 4, s = v & 15;
        if (i < 2) {
            const int b = bh >> 3, h = bh & 7, qb = (i == 0) ? s : 31 - s;
            attn_unit<96, 64>(lds, QM + (size_t)b * SEQ * 768 + h * 96, 768, KM + (size_t)b * SEQ * 768 + h * 96, 768, VMT + (size_t)(b * 8 + h) * 64 * SEQ, OM + (size_t)b * SEQ * 512 + h * 64, 512, qb);
        } else {
            const int b = bh >> 3, h = (bh >> 1) & 3, c = bh & 1, qb = (i == 2) ? 15 - s : 16 + s;
            attn_unit<64, 128>(lds, QD + (size_t)b * SEQ * 512 + (h * 2 + c) * 64, 512, KD + (size_t)b * SEQ * 512 + (h * 2 + c) * 64, 512, VDT + (size_t)(b * 4 + h) * 128 * SEQ, ODR + (size_t)b * SEQ * 1024 + (h * 2 + c) * 128, 1024, qb);
        }
    }
    GRID_SYNC();

    if (PH(5)) {
        pg8::Gemm g{OM, W3A, M, D, 512}; pg8::StaticOrder S; S.init(M, D, G, bx);
        EpiBranch<0> E{GATES, TMP, MERGED};
        pg8::gemm_phase<EpiBranch<0>, pg8::StaticOrder, true, true>(lds, g, S, E);
    }
    if (PH(6)) {
        const float d1 = wave_sum(a.lq1[lane] * a.lk1[lane]), d2 = wave_sum(a.lq2[lane] * a.lk2[lane]);
        const float lam = expf(d1) - expf(d2) + LAMBDA_INIT;
        f32x4 g0 = *(const f32x4*)(a.subln_g + 8 * (lane & 15)), g1 = *(const f32x4*)(a.subln_g + 8 * (lane & 15) + 4);
        g0 = g0 * (1.f - LAMBDA_INIT); g1 = g1 * (1.f - LAMBDA_INIT);
        for (int m = gw; m < M; m += NGW) {
            const int h = lane >> 4, dd = 8 * (lane & 15);
            const v4u w1 = *(const v4u*)(ODR + (size_t)m * 1024 + h * 256 + dd), w2 = *(const v4u*)(ODR + (size_t)m * 1024 + h * 256 + 128 + dd);
            float v[8];
#pragma unroll
            for (int k = 0; k < 4; ++k) { v[2 * k] = bf2f(w1[k] & 0xffffu) - lam * bf2f(w2[k] & 0xffffu); v[2 * k + 1] = bf2f(w1[k] >> 16) - lam * bf2f(w2[k] >> 16); }
            float s = 0.f;
#pragma unroll
            for (int k = 0; k < 8; ++k) s += v[k] * v[k];
            s += __shfl_xor(s, 1); s += __shfl_xor(s, 2); s += __shfl_xor(s, 4); s += __shfl_xor(s, 8);
            const float rs = rsqrtf(s * (1.f / 128.f) + EPS);
            const f32x4 o0 = {v[0] * rs * g0[0], v[1] * rs * g0[1], v[2] * rs * g0[2], v[3] * rs * g0[3]}, o1 = {v[4] * rs * g1[0], v[5] * rs * g1[1], v[6] * rs * g1[2], v[7] * rs * g1[3]};
            *(v4u*)(ODN + (size_t)m * 512 + h * 128 + dd) = pack8(o0, o1);
        }
    }
    GRID_SYNC();

    if (PH(7)) {
        pg8::Gemm g{ODN, W3B, M, D, 512}; pg8::StaticOrder S; S.init(M, D, G, bx);
        EpiBranch<1> E{GATES, TMP, MERGED};
        pg8::gemm_phase<EpiBranch<1>, pg8::StaticOrder, true, true>(lds, g, S, E);
    }
    GRID_SYNC();

    if (PH(8)) {
        pg8::Gemm g{MERGED, W4, M, D, D}; pg8::StaticOrder S; S.init(M, D, G, bx);
        EpiRes E{a.x, a.out, X1B, ss1};
        pg8::gemm_phase<EpiRes, pg8::StaticOrder, true, true>(lds, g, S, E);
    }
    GRID_SYNC();

    if (PH(9)) {
        pg8::Gemm g{X1B, W5, M, 2 * FF, D}; pg8::StaticOrder S; S.init(M, 2 * FF, G, bx);
        EpiSwiglu E{HB, ss1};
        pg8::gemm_phase<EpiSwiglu, pg8::StaticOrder, true, true>(lds, g, S, E);
    }
    GRID_SYNC();

    if (PH(10)) {
        pg8::Gemm g{HB, W6, M, D, FF}; pg8::StaticOrder S; S.init(M, D, G, bx);
        EpiRes E{a.out, a.out, nullptr, ss2};
        pg8::gemm_phase<EpiRes, pg8::StaticOrder, true, true>(lds, g, S, E);
    }
    GRID_SYNC();

    if (PH(11)) for (int m = gw; m < M; m += NGW) {
        f32x4* xr = (f32x4*)(a.out + (size_t)m * D) + lane; const f32x4* gr = (const f32x4*)a.norm_final_g + lane;
        float sq = ss2[(size_t)m * 16 + (lane & 15)];
        sq += __shfl_xor(sq, 1); sq += __shfl_xor(sq, 2); sq += __shfl_xor(sq, 4); sq += __shfl_xor(sq, 8);
        const float rs = rsqrtf(sq * (1.f / D) + EPS);
#pragma unroll
        for (int j = 0; j < 4; ++j) xr[64 * j] = xr[64 * j] * rs * gr[64 * j];
    }
}

extern "C" void kernel_launch(void* const* d_in, const int* in_sizes, int n_in, void* d_out, int out_size, void* d_ws, size_t ws_size, hipStream_t stream) {
    static int grid = 0;
    if (grid == 0) {
        if (n_in != 22 || in_sizes[0] != M * D || out_size != M * D || ws_size < WS_END) { fprintf(stderr, "kernel_launch: unexpected shapes (n_in %d, ws %zu)\n", n_in, ws_size); grid = -1; return; }
        int dev = 0, cus = 0, per_cu = 0;
        hipGetDevice(&dev); hipDeviceGetAttribute(&cus, hipDeviceAttributeMultiprocessorCount, dev);
        hipFuncSetAttribute((const void*)fwd_megakernel, hipFuncAttributeMaxDynamicSharedMemorySize, LDS_BYTES);
        hipOccupancyMaxActiveBlocksPerMultiprocessor(&per_cu, (const void*)fwd_megakernel, 512, LDS_BYTES);
        if (per_cu < 1) { fprintf(stderr, "kernel_launch: occupancy query says %d blocks per CU\n", per_cu); per_cu = 1; }
        grid = cus * (per_cu > 1 ? 1 : per_cu);
        (void)hipGetLastError();
    }
    if (grid < 0) return;
    if (hipMemsetAsync(d_ws, 0, 65536, stream) != hipSuccess) { fprintf(stderr, "kernel_launch: memset failed\n"); return; }
    Args a{};
    a.x = (const float*)d_in[0]; a.positions = (const int*)d_in[1]; a.norm_mix_g = (const float*)d_in[2]; a.w_in = (const float*)d_in[3]; a.b_gate = (const float*)d_in[4];
    a.mla_q_norm_g = (const float*)d_in[5]; a.mla_w_uq = (const float*)d_in[6]; a.mla_kv_norm_g = (const float*)d_in[7]; a.mla_w_ukv = (const float*)d_in[8];
    a.lq1 = (const float*)d_in[9]; a.lk1 = (const float*)d_in[10]; a.lq2 = (const float*)d_in[11]; a.lk2 = (const float*)d_in[12]; a.subln_g = (const float*)d_in[13];
    a.w_branch_mla = (const float*)d_in[14]; a.w_branch_diff = (const float*)d_in[15]; a.w_out = (const float*)d_in[16]; a.norm_ffn_g = (const float*)d_in[17];
    a.w_ffn_gate = (const float*)d_in[18]; a.w_ffn_up = (const float*)d_in[19]; a.w_ffn_down = (const float*)d_in[20]; a.norm_final_g = (const float*)d_in[21];
    a.out = (float*)d_out; a.ws = (unsigned char*)d_ws;
    void* args[] = {&a};
    hipError_t e = hipLaunchCooperativeKernel((const void*)fwd_megakernel, dim3(grid), dim3(512), args, LDS_BYTES, stream);
    if (e != hipSuccess) fprintf(stderr, "cooperative launch failed: %s (grid %d)\n", hipGetErrorString(e), grid);
}
```

```cpp
#include <hip/hip_runtime.h>
#include <hip/hip_cooperative_groups.h>
#include <cstdio>
#include <cstdint>
namespace cg = cooperative_groups;
namespace pg8 {
#define PG8_LAS __attribute__((address_space(3)))
typedef unsigned short bf16_t;
typedef short bf16x8 __attribute__((ext_vector_type(8)));
typedef float f32x4 __attribute__((ext_vector_type(4)));
typedef unsigned u32x4 __attribute__((ext_vector_type(4)));
constexpr int BM = 256, BK = 64, HALF = 128, HTB = HALF * BK * 2  , STAGE_BYTES = 8 * HTB, NXCD = 8, WGM = 8;

__host__ __device__ __forceinline__ int lds_byte(int r, int c) { const int st = (r >> 4) * 2 + (c >> 5), rr = r & 15, cc = c & 31, ob = rr * 64 + cc * 2; return st * 1024 + (ob ^ (((ob >> 9) & 1) << 5)); }
__host__ __device__ __forceinline__ void stage_rc(int b, int& R, int& C) { const int st = b / 1024, sb = b % 1024, swz = sb ^ (((sb >> 9) & 1) << 5); R = (st >> 1) * 16 + swz / 64; C = (st & 1) * 32 + (swz % 64) / 2; }
__host__ __device__ __forceinline__ int perm32(int rho) { const int n = rho >> 4, i = rho & 15; return 8 * (i >> 2) + 4 * n + (i & 3); }

struct Unit { int pm, pn; };
struct Gemm { const bf16_t* A; const bf16_t* Bt; int M, N, K; };

struct StaticOrder {
    int nM, nN, nwg, G, c;
    __host__ __device__ void init(int M, int N, int G_, int c_) { nM = M / BM; nN = N / BM; nwg = nM * nN; G = G_; c = c_; }
    __host__ __device__ bool next(int i, Unit& u) const {
        const long L = (long)i * G + c; if (L >= nwg) return false;
        int wgid = (int)L; { const int q = nwg / NXCD, r = nwg % NXCD, xcd = wgid % NXCD, off = wgid / NXCD; wgid = (xcd < r ? xcd * (q + 1) : r * (q + 1) + (xcd - r) * q) + off; }
        const int nig = WGM * nN, gid = wgid / nig, fm = gid * WGM, gsz = (nM - fm) < WGM ? (nM - fm) : WGM;
        u.pm = fm + ((wgid % nig) % gsz); u.pn = (wgid % nig) / gsz; return true;
    }
    __device__ __forceinline__ void a_ready(const Unit&) const {}
    __device__ __forceinline__ void done(const Unit&) const {}
};

typedef float f32x2_t __attribute__((ext_vector_type(2))); typedef __bf16 bf16x2_t __attribute__((ext_vector_type(2)));
__device__ __forceinline__ unsigned cvt_pk_bf16(float lo, float hi) { f32x2_t v = {lo, hi}; bf16x2_t b = __builtin_convertvector(v, bf16x2_t); return __builtin_bit_cast(unsigned, b); }
typedef float f32x2 __attribute__((ext_vector_type(2)));
template <class Epi, class Sched, bool ALIGN_EPI = false, bool SP2 = false>
__device__ __forceinline__ void gemm_phase(PG8_LAS unsigned char* lds, const Gemm g, const Sched& S, const Epi& E) {
    const int tid = threadIdx.x, wid = __builtin_amdgcn_readfirstlane(tid >> 6), lane = tid & 63, wr = wid >> 2, wc = wid & 3, fr = lane & 15, fq = lane >> 4;
    const int K = g.K, nt = K / BK;
    unsigned voffA[2], voffB[2];
#pragma unroll
    for (int i = 0; i < 2; ++i) { int R, C; stage_rc(tid * 16 + i * 8192, R, C); const int Rb = Epi::PERM ? ((R & ~31) + perm32(R & 31)) : R;
        voffA[i] = (unsigned)(R * K + C) * 2u; voffB[i] = (unsigned)(Rb * K + C) * 2u; }
    const size_t kstep = (size_t)(BK * 2);
    const size_t hstep = (size_t)HALF * K * 2;
    const size_t tstep = 2 * hstep;
    const unsigned ldsw = (unsigned)wid * 1024u;
    const int aoff = lds_byte(wr * 64 + fr, fq * 8), boff = lds_byte(wc * 32 + fr, fq * 8);
#define PG8_SA(b, h) (((b) * 2 + (h)) * HTB)
#define PG8_SB(b, h) ((4 + (b) * 2 + (h)) * HTB)
#define PG8_STAGE(bufoff, gbase, voff) do { _Pragma("unroll") for (int _i = 0; _i < 2; ++_i) \
        __builtin_amdgcn_global_load_lds((const unsigned*)((const char*)(gbase) + (voff)[_i]), (PG8_LAS unsigned*)(lds + (bufoff) + ldsw + _i * 8192), 16, 0, 0); } while (0)
#define PG8_LDA(dst, b, h) do { _Pragma("unroll") for (int m = 0; m < 4; ++m) _Pragma("unroll") for (int k = 0; k < 2; ++k) dst[m][k] = *(const PG8_LAS bf16x8*)(lds + PG8_SA(b, h) + aoff + m * 2048 + k * 1024); } while (0)
#define PG8_LDB(dst, b, h) do { _Pragma("unroll") for (int n = 0; n < 2; ++n) _Pragma("unroll") for (int k = 0; k < 2; ++k) dst[n][k] = *(const PG8_LAS bf16x8*)(lds + PG8_SB(b, h) + boff + n * 2048 + k * 1024); } while (0)
#define PG8_MMA(ai, bj, At, Bt) do { __builtin_amdgcn_s_setprio(1); _Pragma("unroll") for (int m = 0; m < 4; ++m) _Pragma("unroll") for (int n = 0; n < 2; ++n) _Pragma("unroll") for (int k = 0; k < 2; ++k) \
        acc[ai][bj][m][n] = __builtin_amdgcn_mfma_f32_16x16x32_bf16(Bt[n][k], At[m][k], acc[ai][bj][m][n], 0, 0, 0); __builtin_amdgcn_s_setprio(0); } while (0)
#define PG8_WAIT_V(n) asm volatile("s_waitcnt vmcnt(" #n ")" ::: "memory")
#define PG8_WAIT_L(n) asm volatile("s_waitcnt lgkmcnt(" #n ")" ::: "memory")
#define PG8_BAR __builtin_amdgcn_s_barrier()
#define PG8_SCHED __builtin_amdgcn_sched_barrier(0)
    Unit cur, nxt; int ui = 0;
    if (!S.next(0, cur)) return;
    f32x4 acc[2][2][4][2];
#pragma unroll
    for (int a = 0; a < 2; ++a)
#pragma unroll
        for (int b = 0; b < 2; ++b)
#pragma unroll
            for (int m = 0; m < 4; ++m)
#pragma unroll
                for (int n = 0; n < 2; ++n) acc[a][b][m][n] = (f32x4){0.f, 0.f, 0.f, 0.f};
    bf16x8 At[4][2], B0[2][2], B1[2][2];
    const char* cA = (const char*)g.A + (size_t)cur.pm * tstep; const char* cB = (const char*)g.Bt + (size_t)cur.pn * tstep;
    S.a_ready(cur);
    if constexpr (SP2) {
        PG8_STAGE(PG8_SB(0, 0), cB, voffB); PG8_STAGE(PG8_SB(0, 1), cB + hstep, voffB); PG8_STAGE(PG8_SA(0, 0), cA, voffA); PG8_STAGE(PG8_SA(0, 1), cA + hstep, voffA);
        if (wr == 1) PG8_BAR;
        PG8_WAIT_V(2); PG8_BAR;
        PG8_STAGE(PG8_SB(1, 0), cB + kstep, voffB); PG8_STAGE(PG8_SA(1, 0), cA + kstep, voffA); PG8_STAGE(PG8_SB(1, 1), cB + hstep + kstep, voffB);
        PG8_WAIT_V(6); PG8_BAR;
    } else {
        PG8_STAGE(PG8_SB(0, 0), cB, voffB); PG8_STAGE(PG8_SA(0, 0), cA, voffA); PG8_STAGE(PG8_SB(0, 1), cB + hstep, voffB); PG8_STAGE(PG8_SA(0, 1), cA + hstep, voffA);
        if (wr == 1) PG8_BAR;
        PG8_WAIT_V(4); PG8_BAR;
        PG8_STAGE(PG8_SB(1, 0), cB + kstep, voffB); PG8_STAGE(PG8_SA(1, 0), cA + kstep, voffA); PG8_STAGE(PG8_SB(1, 1), cB + hstep + kstep, voffB);
        PG8_WAIT_V(6); PG8_BAR;
    }
    for (;;) {
        const bool has_next = S.next(ui + 1, nxt);
        const char* nA = has_next ? (const char*)g.A + (size_t)nxt.pm * tstep : cA; const char* nB = has_next ? (const char*)g.Bt + (size_t)nxt.pn * tstep : cB;
#pragma unroll 1
        for (int t = 0; t < nt; t += 2) {
            const bool last = (t == nt - 2);
            const char* a1 = cA + (size_t)(t + 1) * kstep;
            const char* a2 = last ? nA : cA + (size_t)(t + 2) * kstep; const char* b2 = last ? nB : cB + (size_t)(t + 2) * kstep;
            const char* a3 = a2 + kstep; const char* b3 = b2 + kstep;
            if (last && has_next) S.a_ready(nxt);
            if constexpr (SP2) {
            PG8_LDB(B0, 0, 0); PG8_LDB(B1, 0, 1); PG8_SCHED; PG8_LDA(At, 0, 0); PG8_STAGE(PG8_SA(1, 1), a1 + hstep, voffA);
            PG8_WAIT_V(8); PG8_WAIT_L(0); PG8_BAR; PG8_MMA(0, 0, At, B0); PG8_MMA(0, 1, At, B1); PG8_BAR; PG8_SCHED;
            PG8_LDA(At, 0, 1); PG8_STAGE(PG8_SB(0, 0), b2, voffB); PG8_STAGE(PG8_SB(0, 1), b2 + hstep, voffB); PG8_STAGE(PG8_SA(0, 0), a2, voffA);
            PG8_WAIT_V(8); PG8_WAIT_L(0); PG8_BAR; PG8_MMA(1, 0, At, B0); PG8_MMA(1, 1, At, B1); PG8_BAR; PG8_SCHED;
            PG8_LDB(B0, 1, 0); PG8_LDB(B1, 1, 1); PG8_SCHED; PG8_LDA(At, 1, 0); PG8_STAGE(PG8_SA(0, 1), a2 + hstep, voffA);
            PG8_WAIT_V(8); PG8_WAIT_L(0); PG8_BAR; PG8_MMA(0, 0, At, B0); PG8_MMA(0, 1, At, B1); PG8_BAR; PG8_SCHED;
            PG8_LDA(At, 1, 1); PG8_STAGE(PG8_SB(1, 0), b3, voffB); PG8_STAGE(PG8_SB(1, 1), b3 + hstep, voffB); PG8_STAGE(PG8_SA(1, 0), a3, voffA);
            PG8_WAIT_V(8); PG8_WAIT_L(0); PG8_BAR; PG8_MMA(1, 0, At, B0); PG8_MMA(1, 1, At, B1); PG8_BAR; PG8_SCHED;
            } else {
            PG8_LDB(B0, 0, 0); PG8_SCHED; PG8_LDA(At, 0, 0); PG8_STAGE(PG8_SA(1, 1), a1 + hstep, voffA);
            PG8_WAIT_L(8); PG8_BAR; PG8_WAIT_L(0); PG8_MMA(0, 0, At, B0); PG8_BAR; PG8_SCHED;
            PG8_LDB(B1, 0, 1); PG8_STAGE(PG8_SB(0, 0), b2, voffB);
            PG8_BAR; PG8_WAIT_L(0); PG8_MMA(0, 1, At, B1); PG8_BAR;
            PG8_LDA(At, 0, 1); PG8_STAGE(PG8_SA(0, 0), a2, voffA);
            PG8_BAR; PG8_WAIT_L(0); PG8_MMA(1, 0, At, B0); PG8_BAR; PG8_SCHED;
            PG8_STAGE(PG8_SB(0, 1), b2 + hstep, voffB);
            PG8_WAIT_V(6); PG8_BAR; PG8_MMA(1, 1, At, B1); PG8_BAR;
            PG8_LDB(B0, 1, 0); PG8_SCHED; PG8_LDA(At, 1, 0); PG8_STAGE(PG8_SA(0, 1), a2 + hstep, voffA);
            PG8_WAIT_L(8); PG8_BAR; PG8_WAIT_L(0); PG8_MMA(0, 0, At, B0); PG8_BAR; PG8_SCHED;
            PG8_LDB(B1, 1, 1); PG8_STAGE(PG8_SB(1, 0), b3, voffB);
            PG8_BAR; PG8_WAIT_L(0); PG8_MMA(0, 1, At, B1); PG8_BAR;
            PG8_LDA(At, 1, 1); PG8_STAGE(PG8_SA(1, 0), a3, voffA);
            PG8_BAR; PG8_WAIT_L(0); PG8_MMA(1, 0, At, B0); PG8_BAR; PG8_SCHED;
            PG8_STAGE(PG8_SB(1, 1), b3 + hstep, voffB);
            PG8_WAIT_V(6); PG8_BAR; PG8_MMA(1, 1, At, B1); PG8_BAR;
            }
        }
        if constexpr (ALIGN_EPI) { if (wr == 0) PG8_BAR; }
        if constexpr (!Epi::AFTER_DRAIN) { E(acc, cur, wr, wc, fr, fq); S.done(cur); }
        if (!has_next) break;
#pragma unroll
        for (int a = 0; a < 2; ++a)
#pragma unroll
            for (int b = 0; b < 2; ++b)
#pragma unroll
                for (int m = 0; m < 4; ++m)
#pragma unroll
                    for (int n = 0; n < 2; ++n) acc[a][b][m][n] = (f32x4){0.f, 0.f, 0.f, 0.f};
        cur = nxt; cA = nA; cB = nB; ++ui;
        if constexpr (ALIGN_EPI) { if (wr == 1) PG8_BAR; }
    }
    PG8_WAIT_V(0);
    if constexpr (!ALIGN_EPI) { if (wr == 0) PG8_BAR; }
    PG8_BAR;
    if constexpr (Epi::AFTER_DRAIN) { E.fused(acc, cur, wr, wc, fr, fq, lds, wid, lane); S.done(cur); }
#undef PG8_SA
#undef PG8_SB
#undef PG8_STAGE
#undef PG8_LDA
#undef PG8_LDB
#undef PG8_MMA
#undef PG8_WAIT_V
#undef PG8_WAIT_L
#undef PG8_BAR
#undef PG8_SCHED
}
}

#ifndef PH_MASK
#define PH_MASK 0xFFFF
#endif
#define PH(k) ((PH_MASK >> (k)) & 1)
constexpr int NB = 2, SEQ = 8192, M = NB * SEQ, D = 1024;
constexpr int N1 = 4352;
constexpr int FF = 2816;
constexpr float EPS = 1e-6f;
constexpr float LOG2E = 1.4426950408889634f;
constexpr float QS_M = 0.10206207261596577f * LOG2E;
constexpr float QS_D = 0.125f * LOG2E;
constexpr float LAMBDA_INIT = 0.2f;

constexpr size_t MiB = 1u << 20;
constexpr size_t WS_SS = 0;
constexpr size_t WS_TAB = 1 * MiB;
constexpr size_t WS_W1 = 4 * MiB, WS_W2A = 13 * MiB, WS_W2B = 14 * MiB, WS_W3A = 15 * MiB, WS_W3B = 16 * MiB, WS_W4 = 17 * MiB, WS_W5 = 19 * MiB, WS_W6 = 30 * MiB;
constexpr size_t WS_XN = 36 * MiB, WS_QL = 68 * MiB, WS_KVL = 80 * MiB;
constexpr size_t WS_OM = 36 * MiB, WS_ODR = 52 * MiB;
constexpr size_t WS_QD = 88 * MiB, WS_ODN = 88 * MiB;
constexpr size_t WS_KD = 104 * MiB, WS_VDT = 120 * MiB, WS_MERGED = 104 * MiB;
constexpr size_t WS_QM = 136 * MiB, WS_KM = 160 * MiB, WS_VMT = 184 * MiB, WS_TMP = 136 * MiB;
constexpr size_t WS_X1B = 200 * MiB;
constexpr size_t WS_H = 36 * MiB;
constexpr size_t WS_PART = 232 * MiB;
constexpr size_t WS_END = 236 * MiB;

constexpr int LDS_BYTES = 147456;

#define LAS __attribute__((address_space(3)))
typedef unsigned short bf16;
typedef unsigned v4u __attribute__((ext_vector_type(4)));
typedef unsigned v2u __attribute__((ext_vector_type(2)));
typedef float f32x4 __attribute__((ext_vector_type(4)));
typedef float f32x16 __attribute__((ext_vector_type(16)));
typedef short bf16x8 __attribute__((ext_vector_type(8)));
using pg8::cvt_pk_bf16;
#define LDS_WAIT() asm volatile("s_waitcnt lgkmcnt(0)" ::: "memory")
__device__ __forceinline__ unsigned f2bf(float f) { unsigned u = __builtin_bit_cast(unsigned, f); return (u + 0x7fffu + ((u >> 16) & 1u)) >> 16; }
__device__ __forceinline__ unsigned pk2(float lo, float hi) { return f2bf(lo) | (f2bf(hi) << 16); }
__device__ __forceinline__ float bf2f(unsigned h) { return __builtin_bit_cast(float, h << 16); }
__device__ __forceinline__ float wave_sum(float v) {
#pragma unroll
    for (int o = 1; o < 64; o <<= 1) v += __shfl_xor(v, o);
    return v;
}
__device__ __forceinline__ int p16(int k) { return ((k >> 2) & 1) * 8 + (k >> 3) * 4 + (k & 3); }
__device__ __forceinline__ float sigmoidf_(float v) { return __builtin_amdgcn_rcpf(1.f + __builtin_amdgcn_exp2f(-v * LOG2E)); }
__device__ __forceinline__ v2u pack4(f32x4 v) { v2u r; r.x = cvt_pk_bf16(v[0], v[1]); r.y = cvt_pk_bf16(v[2], v[3]); return r; }
__device__ __forceinline__ v4u pack8(f32x4 a, f32x4 b) { v4u r; r.x = cvt_pk_bf16(a[0], a[1]); r.y = cvt_pk_bf16(a[2], a[3]); r.z = cvt_pk_bf16(b[0], b[1]); r.w = cvt_pk_bf16(b[2], b[3]); return r; }

using pg8::Unit;
struct EpiInProj {
    static constexpr bool PERM = true, AFTER_DRAIN = false;
    bf16 *Qd, *Kd, *VdT, *GATES, *QL, *KVL, *Km; const float *bgate, *tdc, *tds, *tmc, *tms; float *ssq, *sskv;
    __device__ __forceinline__ void operator()(const f32x4 (&acc)[2][2][4][2], const Unit& u, int wr, int wc, int fr, int fq) const {
        const int pn = u.pn; const int row0 = u.pm * 256 + wr * 64 + fr;
        if (pn < 4) {
            bf16* dst = pn < 2 ? Qd : Kd; const float sc = pn < 2 ? QS_D : 1.f; const int cb = (pn & 1) * 256 + wc * 32 + 8 * fq;
            const bool rope = (wc & 1) == 0;
#pragma unroll
            for (int ai = 0; ai < 2; ++ai)
#pragma unroll
                for (int m = 0; m < 4; ++m) {
                    const int row = row0 + ai * 128 + m * 16;
                    f32x4 c0 = {1.f, 1.f, 1.f, 1.f}, c1 = c0, s0 = {0.f, 0.f, 0.f, 0.f}, s1 = s0;
                    if (rope) { c0 = *(const f32x4*)(tdc + (size_t)row * 8); c1 = *(const f32x4*)(tdc + (size_t)row * 8 + 4); s0 = *(const f32x4*)(tds + (size_t)row * 8); s1 = *(const f32x4*)(tds + (size_t)row * 8 + 4); }
#pragma unroll
                    for (int bj = 0; bj < 2; ++bj) {
                        f32x4 v0 = acc[ai][bj][m][0], v1 = acc[ai][bj][m][1];
                        if (rope) {
#pragma unroll
                            for (int j = 0; j < 4; ++j) {
                                const float p0 = __shfl_xor(v0[j], 16), p1 = __shfl_xor(v1[j], 16);
                                if (fq == 0) { v0[j] = v0[j] * c0[j] - p0 * s0[j]; v1[j] = v1[j] * c1[j] - p1 * s1[j]; }
                                else if (fq == 1) { v0[j] = v0[j] * c0[j] + p0 * s0[j]; v1[j] = v1[j] * c1[j] + p1 * s1[j]; }
                            }
                        }
                        v0 = v0 * sc; v1 = v1 * sc;
                        *(v4u*)(dst + (size_t)row * 512 + cb + bj * 128) = pack8(v0, v1);
                    }
                }
        } else if (pn < 6) {
#pragma unroll
            for (int ai = 0; ai < 2; ++ai)
#pragma unroll
                for (int m = 0; m < 4; ++m) {
                    const int row = row0 + ai * 128 + m * 16; const int b = row >> 13, pos = row & (SEQ - 1), pp = (pos & ~15) | p16(pos & 15);
#pragma unroll
                    for (int bj = 0; bj < 2; ++bj) {
                        const int h = (pn - 4) * 2 + bj;
                        bf16* base = VdT + ((size_t)((b * 4 + h) * 128 + wc * 32 + 8 * fq)) * SEQ + pp;
#pragma unroll
                        for (int n = 0; n < 2; ++n)
#pragma unroll
                            for (int j = 0; j < 4; ++j) base[(size_t)(4 * n + j) * SEQ] = (bf16)f2bf(acc[ai][bj][m][n][j]);
                    }
                }
        } else if (pn < 14) {
            const int cb = (pn - 6) * 256 + wc * 32 + 8 * fq;
            f32x4 bv[2][2];
#pragma unroll
            for (int bj = 0; bj < 2; ++bj) { bv[bj][0] = *(const f32x4*)(bgate + cb + bj * 128); bv[bj][1] = *(const f32x4*)(bgate + cb + bj * 128 + 4); }
#pragma unroll
            for (int ai = 0; ai < 2; ++ai)
#pragma unroll
                for (int m = 0; m < 4; ++m) {
                    const int row = row0 + ai * 128 + m * 16;
#pragma unroll
                    for (int bj = 0; bj < 2; ++bj) {
                        f32x4 v0 = acc[ai][bj][m][0] + bv[bj][0], v1 = acc[ai][bj][m][1] + bv[bj][1];
#pragma unroll
                        for (int j = 0; j < 4; ++j) { v0[j] = sigmoidf_(v0[j]); v1[j] = sigmoidf_(v1[j]); }
                        *(v4u*)(GATES + (size_t)row * 2048 + cb + bj * 128) = pack8(v0, v1);
                    }
                }
        } else {
#pragma unroll
            for (int bj = 0; bj < 2; ++bj) {
                const int hh = 2 * (pn - 14) + bj;
                if (hh <= 4) {
                    bf16* dst; int ld, cb; float* ss; int sld;
                    if (hh <= 2) { dst = QL; ld = 384; cb = hh * 128; ss = ssq + hh * 4 + wc; sld = 16; } else { dst = KVL; ld = 256; cb = (hh - 3) * 128; ss = sskv + (hh - 3) * 4 + wc; sld = 8; }
                    cb += wc * 32 + 8 * fq;
#pragma unroll
                    for (int ai = 0; ai < 2; ++ai)
#pragma unroll
                        for (int m = 0; m < 4; ++m) {
                            const int row = row0 + ai * 128 + m * 16;
                            const f32x4 v0 = acc[ai][bj][m][0], v1 = acc[ai][bj][m][1];
                            float s = (v0[0] * v0[0] + v0[1] * v0[1]) + (v0[2] * v0[2] + v0[3] * v0[3]) + (v1[0] * v1[0] + v1[1] * v1[1]) + (v1[2] * v1[2] + v1[3] * v1[3]);
                            s += __shfl_xor(s, 16); s += __shfl_xor(s, 32);
                            if (fq == 0) ss[(size_t)row * sld] = s;
                            *(v4u*)(dst + (size_t)row * ld + cb) = pack8(v0, v1);
                        }
                } else if (wc == 0) {
#pragma unroll
                    for (int ai = 0; ai < 2; ++ai)
#pragma unroll
                        for (int m = 0; m < 4; ++m) {
                            const int row = row0 + ai * 128 + m * 16;
                            const f32x4 c0 = *(const f32x4*)(tmc + (size_t)row * 16 + 8 * (fq & 1)), c1 = *(const f32x4*)(tmc + (size_t)row * 16 + 8 * (fq & 1) + 4);
                            const f32x4 s0 = *(const f32x4*)(tms + (size_t)row * 16 + 8 * (fq & 1)), s1 = *(const f32x4*)(tms + (size_t)row * 16 + 8 * (fq & 1) + 4);
                            f32x4 v0 = acc[ai][bj][m][0], v1 = acc[ai][bj][m][1];
#pragma unroll
                            for (int j = 0; j < 4; ++j) {
                                const float p0 = __shfl_xor(v0[j], 32), p1 = __shfl_xor(v1[j], 32);
                                if (fq < 2) { v0[j] = v0[j] * c0[j] - p0 * s0[j]; v1[j] = v1[j] * c1[j] - p1 * s1[j]; }
                                else { v0[j] = v0[j] * c0[j] + p0 * s0[j]; v1[j] = v1[j] * c1[j] + p1 * s1[j]; }
                            }
                            const v4u w = pack8(v0, v1);
#pragma unroll
                            for (int h = 0; h < 8; ++h) *(v4u*)(Km + (size_t)row * 768 + h * 96 + 64 + 8 * fq) = w;
                        }
                }
            }
        }
    }
};
struct EpiQup {
    static constexpr bool PERM = false, AFTER_DRAIN = false;
    bf16* Qm; const float *ssq, *tmc, *tms;
    __device__ __forceinline__ void operator()(const f32x4 (&acc)[2][2][4][2], const Unit& u, int wr, int wc, int fr, int fq) const {
        const int row0 = u.pm * 256 + wr * 64 + fr;
#pragma unroll
        for (int ai = 0; ai < 2; ++ai)
#pragma unroll
            for (int m = 0; m < 4; ++m) {
                const int row = row0 + ai * 128 + m * 16;
                const f32x4 pa = *(const f32x4*)(ssq + (size_t)row * 16), pb = *(const f32x4*)(ssq + (size_t)row * 16 + 4), pc = *(const f32x4*)(ssq + (size_t)row * 16 + 8);
                const float sq = ((pa[0] + pa[1]) + (pa[2] + pa[3])) + ((pb[0] + pb[1]) + (pb[2] + pb[3])) + ((pc[0] + pc[1]) + (pc[2] + pc[3]));
                const float rs = rsqrtf(sq * (1.f / 384.f) + EPS) * QS_M;
#pragma unroll
                for (int bj = 0; bj < 2; ++bj) {
                    const int gi = 8 * u.pn + 4 * bj + wc, part = gi % 3;
                    f32x4 v0 = acc[ai][bj][m][0] * rs, v1 = acc[ai][bj][m][1] * rs;
                    if (part == 2) {
                        const f32x4 c = *(const f32x4*)(tmc + (size_t)row * 16 + 4 * fq), s = *(const f32x4*)(tms + (size_t)row * 16 + 4 * fq);
                        const f32x4 o0 = v0 * c - v1 * s, o1 = v1 * c + v0 * s; v0 = o0; v1 = o1;
                    }
                    bf16* p = Qm + (size_t)row * 768 + 32 * gi + 4 * fq;
                    *(v2u*)p = pack4(v0); *(v2u*)(p + 16) = pack4(v1);
                }
                asm volatile("" ::: "memory");
            }
    }
};
struct EpiKVup {
    static constexpr bool PERM = false, AFTER_DRAIN = false;
    bf16 *Km, *VmT; const float* sskv;
    __device__ __forceinline__ void operator()(const f32x4 (&acc)[2][2][4][2], const Unit& u, int wr, int wc, int fr, int fq) const {
        const int row0 = u.pm * 256 + wr * 64 + fr;
#pragma unroll
        for (int ai = 0; ai < 2; ++ai)
#pragma unroll
            for (int m = 0; m < 4; ++m) {
                const int row = row0 + ai * 128 + m * 16; const int b = row >> 13, pos = row & (SEQ - 1), pp = (pos & ~15) | p16(pos & 15);
                const f32x4 pa = *(const f32x4*)(sskv + (size_t)row * 8), pb = *(const f32x4*)(sskv + (size_t)row * 8 + 4);
                const float rs = rsqrtf((((pa[0] + pa[1]) + (pa[2] + pa[3])) + ((pb[0] + pb[1]) + (pb[2] + pb[3]))) * (1.f / 256.f) + EPS);
#pragma unroll
                for (int bj = 0; bj < 2; ++bj) {
                    const int head = 2 * u.pn + bj;
                    const f32x4 v0 = acc[ai][bj][m][0] * rs, v1 = acc[ai][bj][m][1] * rs;
                    if (wc < 2) {
                        bf16* p = Km + (size_t)row * 768 + head * 96 + 32 * wc + 4 * fq;
                        *(v2u*)p = pack4(v0); *(v2u*)(p + 16) = pack4(v1);
                    } else {
                        bf16* base = VmT + ((size_t)((b * 8 + head) * 64 + 32 * (wc - 2) + 4 * fq)) * SEQ + pp;
#pragma unroll
                        for (int j = 0; j < 4; ++j) { base[(size_t)j * SEQ] = (bf16)f2bf(v0[j]); base[(size_t)(16 + j) * SEQ] = (bf16)f2bf(v1[j]); }
                    }
                }
                asm volatile("" ::: "memory");
            }
    }
};
template <int STEP> struct EpiBranch {
    static constexpr bool PERM = false, AFTER_DRAIN = false;
    const bf16* GATES; float* TMP; bf16* MERGED;
    __device__ __forceinline__ void operator()(const f32x4 (&acc)[2][2][4][2], const Unit& u, int wr, int wc, int fr, int fq) const {
        const int row0 = u.pm * 256 + wr * 64 + fr, col0 = u.pn * 256 + wc * 32 + 4 * fq;
#pragma unroll
        for (int ai = 0; ai < 2; ++ai)
#pragma unroll
            for (int m = 0; m < 4; ++m) {
                const int row = row0 + ai * 128 + m * 16;
#pragma unroll
                for (int bj = 0; bj < 2; ++bj)
#pragma unroll
                    for (int n = 0; n < 2; ++n) {
                        const int col = col0 + bj * 128 + n * 16;
                        const v2u gw = *(const v2u*)(GATES + (size_t)row * 2048 + STEP * 1024 + col);
                        const f32x4 g = {bf2f(gw.x & 0xffffu), bf2f(gw.x >> 16), bf2f(gw.y & 0xffffu), bf2f(gw.y >> 16)};
                        float* tp = TMP + (size_t)row * 1024 + col;
                        if (STEP == 0) *(f32x4*)tp = acc[ai][bj][m][n] * g;
                        else { const f32x4 t = *(const f32x4*)tp; *(v2u*)(MERGED + (size_t)row * 1024 + col) = pack4(t + acc[ai][bj][m][n] * g); }
                    }
            }
    }
};
struct EpiRes {
    static constexpr bool PERM = false, AFTER_DRAIN = false;
    const float* base; float* out; bf16* outb; float* ss;
    __device__ __forceinline__ void operator()(const f32x4 (&acc)[2][2][4][2], const Unit& u, int wr, int wc, int fr, int fq) const {
        const int row0 = u.pm * 256 + wr * 64 + fr, col0 = u.pn * 256 + wc * 32 + 4 * fq;
#pragma unroll
        for (int ai = 0; ai < 2; ++ai)
#pragma unroll
            for (int m = 0; m < 4; ++m) {
                const int row = row0 + ai * 128 + m * 16; float s = 0.f;
#pragma unroll
                for (int bj = 0; bj < 2; ++bj)
#pragma unroll
                    for (int n = 0; n < 2; ++n) {
                        const size_t off = (size_t)row * 1024 + col0 + bj * 128 + n * 16;
                        const f32x4 v = *(const f32x4*)(base + off) + acc[ai][bj][m][n];
                        s += (v[0] * v[0] + v[1] * v[1]) + (v[2] * v[2] + v[3] * v[3]);
                        *(f32x4*)(out + off) = v;
                        if (outb) *(v2u*)(outb + off) = pack4(v);
                    }
                s += __shfl_xor(s, 16); s += __shfl_xor(s, 32);
                if (fq == 0) ss[(size_t)row * 16 + u.pn * 4 + wc] = s;
            }
    }
};
struct EpiSwiglu {
    static constexpr bool PERM = true, AFTER_DRAIN = false;
    bf16* H; const float* ss1;
    __device__ __forceinline__ void operator()(const f32x4 (&acc)[2][2][4][2], const Unit& u, int wr, int wc, int fr, int fq) const {
        const int row0 = u.pm * 256 + wr * 64 + fr, col0 = u.pn * 128 + wc * 32 + 8 * fq;
#pragma unroll
        for (int ai = 0; ai < 2; ++ai)
#pragma unroll
            for (int m = 0; m < 4; ++m) {
                const int row = row0 + ai * 128 + m * 16;
                float sq = 0.f;
#pragma unroll
                for (int k = 0; k < 4; ++k) { const f32x4 p = *(const f32x4*)(ss1 + (size_t)row * 16 + 4 * k); sq += (p[0] + p[1]) + (p[2] + p[3]); }
                const float rs = rsqrtf(sq * (1.f / 1024.f) + EPS);
                f32x4 o[2];
#pragma unroll
                for (int n = 0; n < 2; ++n) {
                    const f32x4 g = acc[ai][0][m][n] * rs, up = acc[ai][1][m][n] * rs;
#pragma unroll
                    for (int j = 0; j < 4; ++j) o[n][j] = g[j] * sigmoidf_(g[j]) * up[j];
                }
                *(v4u*)(H + (size_t)row * FF + col0) = pack8(o[0], o[1]);
            }
    }
};

template <int DK, int DV>
__device__ __forceinline__ void attn_unit(LAS unsigned char* lds, const bf16* Qp, int ldq, const bf16* Kp, int ldk, const bf16* VTp, bf16* Op, int ldo, int qb) {
    constexpr int KC = DK / 8, KP = DK * 2 + 16, VP = 144, KTB = 64 * KP, BUF = KTB + DV * VP;
    constexpr int KCH = 64 * KC, VCH = DV * 8, NKL = (KCH + 511) / 512, NVL = VCH / 512, NDB = DV / 32, NQC = DK / 16;
    const int tid = threadIdx.x, lane = tid & 63, w = __builtin_amdgcn_readfirstlane(tid >> 6), q = lane & 31, hi = lane >> 5;
    const bool grpB = w >= 4;
    const int q0 = qb * 256, NT = 4 * (qb + 1);
    LAS bf16x8* qsp = (LAS bf16x8*)(lds + 3 * BUF + w * (NQC * 1024)) + lane;
    { const bf16* qrow = Qp + (size_t)(q0 + 32 * w + q) * ldq + 8 * hi;
#pragma unroll
      for (int c = 0; c < NQC; ++c) qsp[c * 64] = *(const bf16x8*)(qrow + 16 * c); }
    v4u kra[NKL], vra[NVL], krb[NKL], vrb[NVL];
#define ATT_LOAD(t, KR, VR) do { \
    _Pragma("unroll") for (int i_ = 0; i_ < NKL; ++i_) { int id_ = tid + 512 * i_; if ((KCH % 512 != 0) && id_ >= KCH) id_ -= 512; { const int r_ = id_ / KC, c_ = id_ % KC; KR[i_] = *(const v4u*)(Kp + (size_t)(64 * (t) + r_) * ldk + c_ * 8); } } \
    _Pragma("unroll") for (int i_ = 0; i_ < NVL; ++i_) { const int id_ = tid + 512 * i_; const int d_ = id_ >> 3, c_ = id_ & 7; VR[i_] = *(const v4u*)(VTp + (size_t)d_ * SEQ + 64 * (t) + c_ * 8); } } while (0)
#define ATT_STORE(boff, KR, VR) do { \
    _Pragma("unroll") for (int i_ = 0; i_ < NKL; ++i_) { int id_ = tid + 512 * i_; if ((KCH % 512 != 0) && id_ >= KCH) id_ -= 512; { const int r_ = id_ / KC, c_ = id_ % KC; *(LAS v4u*)(lds + (boff) + r_ * KP + c_ * 16) = KR[i_]; } } \
    _Pragma("unroll") for (int i_ = 0; i_ < NVL; ++i_) { const int id_ = tid + 512 * i_; const int d_ = id_ >> 3, c_ = id_ & 7; *(LAS v4u*)(lds + (boff) + KTB + d_ * VP + c_ * 16) = VR[i_]; } } while (0)
#define ATT_QK(boff) do { \
    const LAS unsigned char* kb_ = lds + (boff) + q * KP + hi * 16; \
    _Pragma("unroll") for (int c = 0; c < NQC; ++c) { \
        const bf16x8 a0 = *(const LAS bf16x8*)(kb_ + c * 32), a1 = *(const LAS bf16x8*)(kb_ + 32 * KP + c * 32), qc = qsp[c * 64]; \
        if (c == 0) { s0 = __builtin_amdgcn_mfma_f32_32x32x16_bf16(a0, qc, zacc, 0, 0, 0); s1 = __builtin_amdgcn_mfma_f32_32x32x16_bf16(a1, qc, zacc, 0, 0, 0); } \
        else { s0 = __builtin_amdgcn_mfma_f32_32x32x16_bf16(a0, qc, s0, 0, 0, 0); s1 = __builtin_amdgcn_mfma_f32_32x32x16_bf16(a1, qc, s1, 0, 0, 0); } } } while (0)
#define ATT_BAR() do { asm volatile("s_waitcnt lgkmcnt(0)" ::: "memory"); __builtin_amdgcn_s_barrier(); asm volatile("" ::: "memory"); } while (0)
#define ATT_STEP(t, KRL, VRL, KRS, VRS) do { \
    const int t_ = (t); \
    { const int tl_ = t_ + 3 < NT ? t_ + 3 : NT - 1; ATT_LOAD(tl_, KRL, VRL); }     \
    const int tb = t_ - (NT - 4); \
    const bool act = tb < 0 || 64 * tb <= 32 * w + 31, actn = (t_ + 1 < NT) && (tb + 1 < 0 || 64 * (tb + 1) <= 32 * w + 31); \
    v4u pw[4]; \
    if (act) { \
        if (tb >= 0) { const int qrel = 32 * w + q, kb0 = 64 * tb + 4 * hi; \
            _Pragma("unroll") for (int r = 0; r < 16; ++r) { const int kv = kb0 + (r & 3) + 8 * (r >> 2); if (kv > qrel) s0[r] = -INFINITY; if (kv + 32 > qrel) s1[r] = -INFINITY; } } \
        float mxa = fmaxf(fmaxf(s0[0], s0[1]), s0[2]), mxb = fmaxf(fmaxf(s1[0], s1[1]), s1[2]); \
        mxa = fmaxf(fmaxf(mxa, s0[3]), s0[4]); mxb = fmaxf(fmaxf(mxb, s1[3]), s1[4]); \
        _Pragma("unroll") for (int r = 5; r < 15; r += 2) { mxa = fmaxf(fmaxf(mxa, s0[r]), s0[r + 1]); mxb = fmaxf(fmaxf(mxb, s1[r]), s1[r + 1]); } \
        float mx = fmaxf(fmaxf(mxa, mxb), fmaxf(s0[15], s1[15])); \
        mx = fmaxf(mx, __shfl_xor(mx, 32)); \
        if (__any(mx > mrun)) { \
            const float mn = fmaxf(mrun, mx), alpha = __builtin_amdgcn_exp2f(mrun - mn); mrun = mn; lrun *= alpha; \
            _Pragma("unroll") for (int db = 0; db < NDB; ++db) _Pragma("unroll") for (int r = 0; r < 16; ++r) o[db][r] *= alpha; } \
        s0 = s0 - mrun; s1 = s1 - mrun; \
        _Pragma("unroll") for (int r = 0; r < 16; ++r) { s0[r] = __builtin_amdgcn_exp2f(s0[r]); s1[r] = __builtin_amdgcn_exp2f(s1[r]); } \
        { const f32x16 sm = s0 + s1; \
          lrun += (((sm[0] + sm[1]) + (sm[2] + sm[3])) + ((sm[4] + sm[5]) + (sm[6] + sm[7]))) + (((sm[8] + sm[9]) + (sm[10] + sm[11])) + ((sm[12] + sm[13]) + (sm[14] + sm[15]))); } \
        _Pragma("unroll") for (int c4 = 0; c4 < 4; ++c4) { const int b8 = 8 * (c4 & 1); \
            if (c4 < 2) { pw[c4].x = cvt_pk_bf16(s0[b8 + 0], s0[b8 + 1]); pw[c4].y = cvt_pk_bf16(s0[b8 + 2], s0[b8 + 3]); pw[c4].z = cvt_pk_bf16(s0[b8 + 4], s0[b8 + 5]); pw[c4].w = cvt_pk_bf16(s0[b8 + 6], s0[b8 + 7]); } \
            else        { pw[c4].x = cvt_pk_bf16(s1[b8 + 0], s1[b8 + 1]); pw[c4].y = cvt_pk_bf16(s1[b8 + 2], s1[b8 + 3]); pw[c4].z = cvt_pk_bf16(s1[b8 + 4], s1[b8 + 5]); pw[c4].w = cvt_pk_bf16(s1[b8 + 6], s1[b8 + 7]); } } \
    } \
    ATT_BAR(); \
    if (act) { \
        const LAS unsigned char* vb_ = lds + bcur + KTB + q * VP + hi * 16; \
        _Pragma("unroll") for (int c4 = 0; c4 < 4; ++c4) { \
            const bf16x8 pb = __builtin_bit_cast(bf16x8, pw[c4]); \
            _Pragma("unroll") for (int db = 0; db < NDB; ++db) { \
                const bf16x8 va = *(const LAS bf16x8*)(vb_ + db * 32 * VP + c4 * 32); \
                o[db] = __builtin_amdgcn_mfma_f32_32x32x16_bf16(va, pb, o[db], 0, 0, 0); } } \
    } \
    if (actn) ATT_QK(bnext); \
    ATT_STORE(bfree, KRS, VRS); \
    ATT_BAR(); \
    { const int tmp_ = bcur; bcur = bnext; bnext = bfree; bfree = tmp_; } } while (0)

    ATT_LOAD(0, kra, vra); ATT_LOAD(1, krb, vrb);
    ATT_STORE(0, kra, vra); ATT_STORE(BUF, krb, vrb);
    ATT_LOAD(2, krb, vrb);
    __syncthreads();
    float mrun = -1e30f, lrun = 0.f;
    f32x16 o[NDB];
#pragma unroll
    for (int db = 0; db < NDB; ++db)
#pragma unroll
        for (int r = 0; r < 16; ++r) o[db][r] = 0.f;
    f32x16 s0, s1;
    const f32x16 zacc = {0.f, 0.f, 0.f, 0.f, 0.f, 0.f, 0.f, 0.f, 0.f, 0.f, 0.f, 0.f, 0.f, 0.f, 0.f, 0.f};
    ATT_QK(0);
    if (grpB) ATT_BAR();
    int bcur = 0, bnext = BUF, bfree = 2 * BUF;
#pragma unroll 1
    for (int t = 0; t < NT; t += 2) {
        ATT_STEP(t, kra, vra, krb, vrb);
        ATT_STEP(t + 1, krb, vrb, kra, vra);
    }
    if (!grpB) ATT_BAR();
#undef ATT_BAR
#undef ATT_LOAD
#undef ATT_STORE
#undef ATT_QK
#undef ATT_STEP
    lrun += __shfl_xor(lrun, 32);
    const float inv = 1.f / lrun;
    bf16* orow = Op + (size_t)(q0 + 32 * w + q) * ldo + 4 * hi;
#pragma unroll
    for (int db = 0; db < NDB; ++db)
#pragma unroll
        for (int g = 0; g < 4; ++g) {
            const f32x4 v = {o[db][4 * g] * inv, o[db][4 * g + 1] * inv, o[db][4 * g + 2] * inv, o[db][4 * g + 3] * inv};
            *(v2u*)(orow + 32 * db + 8 * g) = pack4(v);
        }
}

__device__ __forceinline__ void tr_item(const float* W, int Nsrc, int src0, const float* g, bf16* WT, int Kdim, int dst_row0, int k0, LAS float* scr, int lane) {
#pragma unroll 8
    for (int i = 0; i < 32; ++i) { const int kk = 2 * i + (lane >> 5); float v = 0.f; if (src0 >= 0) { v = W[(size_t)(k0 + kk) * Nsrc + src0 + (lane & 31)]; if (g) v *= g[k0 + kk]; } scr[kk * 33 + (lane & 31)] = v; }
    LDS_WAIT(); asm volatile("" ::: "memory");
    const int c = lane & 7;
#pragma unroll
    for (int j = 0; j < 4; ++j) { const int n = (lane >> 3) + 8 * j; const LAS float* s = scr + (8 * c) * 33 + n;
        v4u o; o.x = pk2(s[0 * 33], s[1 * 33]); o.y = pk2(s[2 * 33], s[3 * 33]); o.z = pk2(s[4 * 33], s[5 * 33]); o.w = pk2(s[6 * 33], s[7 * 33]);
        *(v4u*)(WT + (size_t)(dst_row0 + n) * Kdim + k0 + 8 * c) = o; }
    LDS_WAIT(); asm volatile("" ::: "memory");
}
__device__ __forceinline__ int inproj_src(int pc) {
    if (pc < 512) return 672 + pc;
    if (pc < 1024) return 1184 + (pc - 512);
    if (pc < 1536) return 1696 + (pc - 1024);
    if (pc < 3584) return 2208 + (pc - 1536);
    if (pc < 3968) return pc - 3584;
    if (pc < 4224) return 384 + (pc - 3968);
    if (pc < 4256) return 640 + (pc - 4224);
    return -1;
}

typedef unsigned v4u_xb __attribute__((ext_vector_type(4)));
#define XB_TMO      128
#define XB_XCNT(j)  (256  + 64 * (j))
#define XB_XSUB(j)  (1280 + 64 * (j))
#define XB_XGEN(j)  (2304 + 64 * (j))
#define XB_TOP      3328
#define XB_TOPGEN   3392
#define XCD_BAR_WORDS 3456
#define XB_SPIN_CAP (1u << 18)

__device__ __forceinline__ unsigned xb_ld(unsigned* p)              { return __hip_atomic_load(p, __ATOMIC_RELAXED, __HIP_MEMORY_SCOPE_AGENT); }
__device__ __forceinline__ unsigned xb_add(unsigned* p, unsigned v) { return __hip_atomic_fetch_add(p, v, __ATOMIC_RELAXED, __HIP_MEMORY_SCOPE_AGENT); }
__device__ __forceinline__ unsigned xb_xcc_id() { return (unsigned)__builtin_amdgcn_s_getreg((3 << 11) | 20) & 0xFu; }
#define XB_SPIN(cond, bar) do { unsigned _sp = 0; while (cond) { __builtin_amdgcn_s_sleep(1); \
    if ((++_sp & 255u) == 0u) { if (xb_ld(&(bar)[XB_TMO])) break; if (_sp > XB_SPIN_CAP) { atomicAdd(&(bar)[XB_TMO], 1u); break; } } } } while (0)

struct XcdBarrier {
    unsigned* bar; unsigned x;
    volatile LAS unsigned* st;
};

__device__ __forceinline__ XcdBarrier xcd_barrier_post(unsigned* bar, volatile LAS unsigned* st) {
    XcdBarrier b; b.bar = bar; b.x = xb_xcc_id(); b.st = st;
    if (threadIdx.x == 0) (void)xb_add(&bar[XB_XCNT(b.x)], 1u);
    return b;
}
__device__ __forceinline__ void xcd_barrier_complete(unsigned* bar, unsigned x, unsigned& nloc, unsigned& nx) {
    const unsigned G = gridDim.x * gridDim.y * gridDim.z;
    unsigned sum, cnt, mine, sp = 0u;
    for (;;) {
        sum = 0u; cnt = 0u; mine = 0u;
#pragma unroll
        for (unsigned j = 0; j < 16; ++j) { const unsigned c = xb_ld(&bar[XB_XCNT(j)]); sum += c; cnt += (c > 0u) ? 1u : 0u; mine = (j == x) ? c : mine; }
        if (sum == G) break;
        __builtin_amdgcn_s_sleep(1);
        if ((++sp & 255u) == 0u) { if (xb_ld(&bar[XB_TMO])) break; if (sp > XB_SPIN_CAP) { atomicAdd(&bar[XB_TMO], 1u); break; } }
    }
    nloc = mine > 0u ? mine : 1u; nx = cnt > 0u ? cnt : 1u;
}

__device__ __forceinline__ void xcd_barrier(const XcdBarrier& b) {
    asm volatile("s_waitcnt vmcnt(0)" ::: "memory");
    __syncthreads();
    if (threadIdx.x == 0) {
        unsigned* bar = b.bar;
        __builtin_amdgcn_s_waitcnt(0);
        unsigned nloc = b.st[0], nx = b.st[1];
        if (nloc == 0u) { xcd_barrier_complete(bar, b.x, nloc, nx); b.st[0] = nloc; b.st[1] = nx; }
        const unsigned old = xb_add(&bar[XB_XSUB(b.x)], 1u);
        const unsigned gen = old / nloc;
        if (old + 1u == (gen + 1u) * nloc) {
            __builtin_amdgcn_fence(__ATOMIC_RELEASE, "agent");
            asm volatile("s_waitcnt vmcnt(0)" ::: "memory");
            const unsigned og = xb_add(&bar[XB_TOP], 1u);
            const unsigned tg = og / nx;
            if (og + 1u == (tg + 1u) * nx) xb_add(&bar[XB_TOPGEN], 1u);
            else XB_SPIN(xb_ld(&bar[XB_TOPGEN]) == tg, bar);
            __builtin_amdgcn_fence(__ATOMIC_ACQUIRE, "agent");
            xb_add(&bar[XB_XGEN(b.x)], 1u);
            asm volatile("s_waitcnt vmcnt(0)" ::: "memory");
        } else {
            XB_SPIN(xb_ld(&bar[XB_XGEN(b.x)]) == gen, bar);
            __builtin_amdgcn_fence(__ATOMIC_ACQUIRE, "agent");
            asm volatile("s_waitcnt vmcnt(0)" ::: "memory");
        }
    }
    __syncthreads();
}

#define GRID_SYNC() xcd_barrier(xbar)
struct Args {
    const float* x; const int* positions; const float *norm_mix_g, *w_in, *b_gate, *mla_q_norm_g, *mla_w_uq, *mla_kv_norm_g, *mla_w_ukv;
    const float *lq1, *lk1, *lq2, *lk2, *subln_g, *w_branch_mla, *w_branch_diff, *w_out, *norm_ffn_g, *w_ffn_gate, *w_ffn_up, *w_ffn_down, *norm_final_g;
    float* out; unsigned char* ws;
};

__global__ void __launch_bounds__(512, 2) fwd_megakernel(Args a) {
    extern __shared__ __attribute__((aligned(16))) unsigned char lds_raw[];
    LAS unsigned char* lds = (LAS unsigned char*)lds_raw;
    cg::grid_group grid = cg::this_grid();
    const int tid = threadIdx.x, lane = tid & 63, wave = __builtin_amdgcn_readfirstlane(tid >> 6);
    const int G = gridDim.x, bx = blockIdx.x;
    const int vcu = (G % 8 == 0) ? (bx % 8) * (G / 8) + bx / 8 : bx;
    const int gw = vcu * 8 + wave, NGW = G * 8;
    unsigned char* ws = a.ws;
    for (int u_ = tid; u_ < 64; u_ += 512) ((LAS unsigned*)(lds + 131072))[u_] = 0u;
    __syncthreads();
    grid.sync();
    XcdBarrier xbar = xcd_barrier_post((unsigned*)(ws + WS_SS) + 4096, (volatile LAS unsigned*)(lds + 131072 + 32));
    float* ssq = (float*)(ws + WS_PART); float* sskv = ssq + (size_t)M * 16; float* ss1 = sskv + (size_t)M * 16; float* ss2 = ss1 + (size_t)M * 16;
    float* tdc = (float*)(ws + WS_TAB); float* tds = tdc + (size_t)M * 8; float* tmc = tds + (size_t)M * 8; float* tms = tmc + (size_t)M * 16;
    bf16 *W1 = (bf16*)(ws + WS_W1), *W2A = (bf16*)(ws + WS_W2A), *W2B = (bf16*)(ws + WS_W2B), *W3A = (bf16*)(ws + WS_W3A), *W3B = (bf16*)(ws + WS_W3B), *W4 = (bf16*)(ws + WS_W4), *W5 = (bf16*)(ws + WS_W5), *W6 = (bf16*)(ws + WS_W6);
    bf16 *XN = (bf16*)(ws + WS_XN), *QL = (bf16*)(ws + WS_QL), *KVL = (bf16*)(ws + WS_KVL), *OM = (bf16*)(ws + WS_OM), *ODR = (bf16*)(ws + WS_ODR);
    bf16 *QD = (bf16*)(ws + WS_QD), *ODN = (bf16*)(ws + WS_ODN), *KD = (bf16*)(ws + WS_KD), *VDT = (bf16*)(ws + WS_VDT), *MERGED = (bf16*)(ws + WS_MERGED);
    bf16 *QM = (bf16*)(ws + WS_QM), *KM = (bf16*)(ws + WS_KM), *VMT = (bf16*)(ws + WS_VMT), *X1B = (bf16*)(ws + WS_X1B), *HB = (bf16*)(ws + WS_H);
    float* TMP = (float*)(ws + WS_TMP);
    bf16* GATES = (bf16*)a.out;

    if (PH(0)) {
        LAS float* scr = (LAS float*)(lds + wave * 16384);
        constexpr int I1 = 16 * (N1 / 32), I2A = 6 * 24, I2B = 4 * 32, I3 = 8 * 32, I4 = 16 * 32, I5 = 16 * (2 * FF / 32), I6 = (FF / 64) * 32;
        constexpr int NITEMS = I1 + I2A + I2B + 2 * I3 + I4 + I5 + I6;
        for (int it = gw; it < NITEMS; it += NGW) {
            int r = it;
            if (r < I1) { const int nb = r % (N1 / 32), kb = r / (N1 / 32); tr_item(a.w_in, 4256, inproj_src(32 * nb), nullptr, W1, 1024, 32 * nb, 64 * kb, scr, lane); continue; } r -= I1;
            if (r < I2A) { const int nb = r % 24, kb = r / 24; tr_item(a.mla_w_uq, 768, 32 * nb, a.mla_q_norm_g, W2A, 384, 32 * nb, 64 * kb, scr, lane); continue; } r -= I2A;
            if (r < I2B) { const int nb = r % 32, kb = r / 32; tr_item(a.mla_w_ukv, 1024, 32 * nb, a.mla_kv_norm_g, W2B, 256, 32 * nb, 64 * kb, scr, lane); continue; } r -= I2B;
            if (r < I3) { const int nb = r % 32, kb = r / 32; tr_item(a.w_branch_mla, 1024, 32 * nb, nullptr, W3A, 512, 32 * nb, 64 * kb, scr, lane); continue; } r -= I3;
            if (r < I3) { const int nb = r % 32, kb = r / 32; tr_item(a.w_branch_diff, 1024, 32 * nb, nullptr, W3B, 512, 32 * nb, 64 * kb, scr, lane); continue; } r -= I3;
            if (r < I4) { const int nb = r % 32, kb = r / 32; tr_item(a.w_out, 1024, 32 * nb, nullptr, W4, 1024, 32 * nb, 64 * kb, scr, lane); continue; } r -= I4;
            if (r < I5) { const int nb = r % (2 * FF / 32), kb = r / (2 * FF / 32); const int pc = 32 * nb, tile = pc >> 8, inner = pc & 255;
                const float* W = inner < 128 ? a.w_ffn_gate : a.w_ffn_up; tr_item(W, FF, 128 * tile + (inner & 127), a.norm_ffn_g, W5, 1024, pc, 64 * kb, scr, lane); continue; } r -= I5;
            { const int nb = r % 32, kb = r / 32; tr_item(a.w_ffn_down, 1024, 32 * nb, nullptr, W6, FF, 32 * nb, 64 * kb, scr, lane); }
        }
        for (int m = gw; m < M; m += NGW) {
            const f32x4* xr = (const f32x4*)(a.x + (size_t)m * D) + lane; const f32x4* gr = (const f32x4*)a.norm_mix_g + lane;
            f32x4 v[4]; float s = 0.f;
#pragma unroll
            for (int j = 0; j < 4; ++j) { v[j] = xr[64 * j]; s += (v[j][0] * v[j][0] + v[j][1] * v[j][1]) + (v[j][2] * v[j][2] + v[j][3] * v[j][3]); }
            const float rs = rsqrtf(wave_sum(s) * (1.f / D) + EPS);
            v2u* o8 = (v2u*)(XN + (size_t)m * D) + lane;
#pragma unroll
            for (int j = 0; j < 4; ++j) o8[64 * j] = pack4(v[j] * rs * gr[64 * j]);
        }
        const int gt = vcu * 512 + tid, NGT = G * 512;
        for (int i = gt; i < M * 24; i += NGT) {
            const int tok = i / 24, f = i % 24; const float pos = (float)a.positions[tok];
            const bool dm = f >= 8; const int fi = dm ? f - 8 : f;
            const float inv = expf((-13.122363377404328f * (float)fi) * (dm ? (2.0f / 32.0f) : (2.0f / 16.0f)));
            const float ang = pos * inv;
            const double ad = (double)ang, kd = rint(ad * 0.15915494309189535), rd = ad - kd * 6.283185307179586;
            const float rr = (float)rd, cs = __cosf(rr), sn = __sinf(rr);
            if (dm) { tmc[(size_t)tok * 16 + fi] = cs; tms[(size_t)tok * 16 + fi] = sn; } else { tdc[(size_t)tok * 8 + fi] = cs; tds[(size_t)tok * 8 + fi] = sn; }
        }
    }
    GRID_SYNC();

    if (PH(1)) {
        pg8::Gemm g{XN, W1, M, N1, D}; pg8::StaticOrder S; S.init(M, N1, G, bx);
        EpiInProj E{QD, KD, VDT, GATES, QL, KVL, KM, a.b_gate, tdc, tds, tmc, tms, ssq, sskv};
        pg8::gemm_phase<EpiInProj, pg8::StaticOrder, true, true>(lds, g, S, E);
    }
    GRID_SYNC();

    if (PH(2)) {
        pg8::Gemm g{KVL, W2B, M, 1024, 256}; pg8::StaticOrder S; S.init(M, 1024, G, bx);
        EpiKVup E{KM, VMT, sskv};
        pg8::gemm_phase<EpiKVup, pg8::StaticOrder, true, true>(lds, g, S, E);
    }
    __syncthreads();
    if (PH(3)) {
        pg8::Gemm g{QL, W2A, M, 768, 384}; pg8::StaticOrder S; S.init(M, 768, G, bx);
        EpiQup E{QM, ssq, tmc, tms};
        pg8::gemm_phase<EpiQup, pg8::StaticOrder, true, true>(lds, g, S, E);
    }
    GRID_SYNC();

    if (PH(4)) {
#pragma unroll 1
        for (int j = vcu; j < 512; j += G) {
            const int i = j >> 8, v = j & 255, bh = v >> 4, s = v & 15;
            const int b = bh >> 3, h = bh & 7, qb = (i == 0) ? s : 31 - s;
            attn_unit<96, 64>(lds, QM + (size_t)b * SEQ * 768 + h * 96, 768, KM + (size_t)b * SEQ * 768 + h * 96, 768, VMT + (size_t)(b * 8 + h) * 64 * SEQ, OM + (size_t)b * SEQ * 512 + h * 64, 512, qb);
        }
#pragma unroll 1
        for (int j = 512 + vcu; j < 1024; j += G) {
            const int i = j >> 8, v = j & 255, bh = v >> 4, s = v & 15;
            const int b = bh >> 3, h = (bh >> 1) & 3, c = bh & 1, qb = (i == 2) ? 15 - s : 16 + s;
            attn_unit<64, 128>(lds, QD + (size_t)b * SEQ * 512 + (h * 2 + c) * 64, 512, KD + (size_t)b * SEQ * 512 + (h * 2 + c) * 64, 512, VDT + (size_t)(b * 4 + h) * 128 * SEQ, ODR + (size_t)b * SEQ * 1024 + (h * 2 + c) * 128, 1024, qb);
        }
    }
    GRID_SYNC();

    if (PH(5)) {
        pg8::Gemm g{OM, W3A, M, D, 512}; pg8::StaticOrder S; S.init(M, D, G, bx);
        EpiBranch<0> E{GATES, TMP, MERGED};
        pg8::gemm_phase<EpiBranch<0>, pg8::StaticOrder, true, true>(lds, g, S, E);
    }
    if (PH(6)) {
        const float d1 = wave_sum(a.lq1[lane] * a.lk1[lane]), d2 = wave_sum(a.lq2[lane] * a.lk2[lane]);
        const float lam = expf(d1) - expf(d2) + LAMBDA_INIT;
        f32x4 g0 = *(const f32x4*)(a.subln_g + 8 * (lane & 15)), g1 = *(const f32x4*)(a.subln_g + 8 * (lane & 15) + 4);
        g0 = g0 * (1.f - LAMBDA_INIT); g1 = g1 * (1.f - LAMBDA_INIT);
        for (int m = gw; m < M; m += NGW) {
            const int h = lane >> 4, dd = 8 * (lane & 15);
            const v4u w1 = *(const v4u*)(ODR + (size_t)m * 1024 + h * 256 + dd), w2 = *(const v4u*)(ODR + (size_t)m * 1024 + h * 256 + 128 + dd);
            float v[8];
#pragma unroll
            for (int k = 0; k < 4; ++k) { v[2 * k] = bf2f(w1[k] & 0xffffu) - lam * bf2f(w2[k] & 0xffffu); v[2 * k + 1] = bf2f(w1[k] >> 16) - lam * bf2f(w2[k] >> 16); }
            float s = 0.f;
#pragma unroll
            for (int k = 0; k < 8; ++k) s += v[k] * v[k];
            s += __shfl_xor(s, 1); s += __shfl_xor(s, 2); s += __shfl_xor(s, 4); s += __shfl_xor(s, 8);
            const float rs = rsqrtf(s * (1.f / 128.f) + EPS);
            const f32x4 o0 = {v[0] * rs * g0[0], v[1] * rs * g0[1], v[2] * rs * g0[2], v[3] * rs * g0[3]}, o1 = {v[4] * rs * g1[0], v[5] * rs * g1[1], v[6] * rs * g1[2], v[7] * rs * g1[3]};
            *(v4u*)(ODN + (size_t)m * 512 + h * 128 + dd) = pack8(o0, o1);
        }
    }
    GRID_SYNC();

    if (PH(7)) {
        pg8::Gemm g{ODN, W3B, M, D, 512}; pg8::StaticOrder S; S.init(M, D, G, bx);
        EpiBranch<1> E{GATES, TMP, MERGED};
        pg8::gemm_phase<EpiBranch<1>, pg8::StaticOrder, true, true>(lds, g, S, E);
    }
    GRID_SYNC();

    if (PH(8)) {
        pg8::Gemm g{MERGED, W4, M, D, D}; pg8::StaticOrder S; S.init(M, D, G, bx);
        EpiRes E{a.x, a.out, X1B, ss1};
        pg8::gemm_phase<EpiRes, pg8::StaticOrder, true, true>(lds, g, S, E);
    }
    GRID_SYNC();

    if (PH(9)) {
        pg8::Gemm g{X1B, W5, M, 2 * FF, D}; pg8::StaticOrder S; S.init(M, 2 * FF, G, bx);
        EpiSwiglu E{HB, ss1};
        pg8::gemm_phase<EpiSwiglu, pg8::StaticOrder, true, true>(lds, g, S, E);
    }
    GRID_SYNC();

    if (PH(10)) {
        pg8::Gemm g{HB, W6, M, D, FF}; pg8::StaticOrder S; S.init(M, D, G, bx);
        EpiRes E{a.out, a.out, nullptr, ss2};
        pg8::gemm_phase<EpiRes, pg8::StaticOrder, true, true>(lds, g, S, E);
    }
    GRID_SYNC();

    if (PH(11)) for (int m = gw; m < M; m += NGW) {
        f32x4* xr = (f32x4*)(a.out + (size_t)m * D) + lane; const f32x4* gr = (const f32x4*)a.norm_final_g + lane;
        float sq = ss2[(size_t)m * 16 + (lane & 15)];
        sq += __shfl_xor(sq, 1); sq += __shfl_xor(sq, 2); sq += __shfl_xor(sq, 4); sq += __shfl_xor(sq, 8);
        const float rs = rsqrtf(sq * (1.f / D) + EPS);
#pragma unroll
        for (int j = 0; j < 4; ++j) xr[64 * j] = xr[64 * j] * rs * gr[64 * j];
    }
}

extern "C" void kernel_launch(void* const* d_in, const int* in_sizes, int n_in, void* d_out, int out_size, void* d_ws, size_t ws_size, hipStream_t stream) {
    static int grid = 0;
    if (grid == 0) {
        if (n_in != 22 || in_sizes[0] != M * D || out_size != M * D || ws_size < WS_END) { fprintf(stderr, "kernel_launch: unexpected shapes (n_in %d, ws %zu)\n", n_in, ws_size); grid = -1; return; }
        int dev = 0, cus = 0, per_cu = 0;
        hipGetDevice(&dev); hipDeviceGetAttribute(&cus, hipDeviceAttributeMultiprocessorCount, dev);
        hipFuncSetAttribute((const void*)fwd_megakernel, hipFuncAttributeMaxDynamicSharedMemorySize, LDS_BYTES);
        hipOccupancyMaxActiveBlocksPerMultiprocessor(&per_cu, (const void*)fwd_megakernel, 512, LDS_BYTES);
        if (per_cu < 1) { fprintf(stderr, "kernel_launch: occupancy query says %d blocks per CU\n", per_cu); per_cu = 1; }
        grid = cus * (per_cu > 1 ? 1 : per_cu);
        (void)hipGetLastError();
    }
    if (grid < 0) return;
    if (hipMemsetAsync(d_ws, 0, 65536, stream) != hipSuccess) { fprintf(stderr, "kernel_launch: memset failed\n"); return; }
    Args a{};
    a.x = (const float*)d_in[0]; a.positions = (const int*)d_in[1]; a.norm_mix_g = (const float*)d_in[2]; a.w_in = (const float*)d_in[3]; a.b_gate = (const float*)d_in[4];
    a.mla_q_norm_g = (const float*)d_in[5]; a.mla_w_uq = (const float*)d_in[6]; a.mla_kv_norm_g = (const float*)d_in[7]; a.mla_w_ukv = (const float*)d_in[8];
    a.lq1 = (const float*)d_in[9]; a.lk1 = (const float*)d_in[10]; a.lq2 = (const float*)d_in[11]; a.lk2 = (const float*)d_in[12]; a.subln_g = (const float*)d_in[13];
    a.w_branch_mla = (const float*)d_in[14]; a.w_branch_diff = (const float*)d_in[15]; a.w_out = (const float*)d_in[16]; a.norm_ffn_g = (const float*)d_in[17];
    a.w_ffn_gate = (const float*)d_in[18]; a.w_ffn_up = (const float*)d_in[19]; a.w_ffn_down = (const float*)d_in[20]; a.norm_final_g = (const float*)d_in[21];
    a.out = (float*)d_out; a.ws = (unsigned char*)d_ws;
    void* args[] = {&a};
    hipError_t e = hipLaunchCooperativeKernel((const void*)fwd_megakernel, dim3(grid), dim3(512), args, LDS_BYTES, stream);
    if (e != hipSuccess) fprintf(stderr, "cooperative launch failed: %s (grid %d)\n", hipGetErrorString(e), grid);
}
```

```cpp
#include <hip/hip_runtime.h>
#include <hip/hip_cooperative_groups.h>
#include <cstdio>
#include <cstdint>
namespace cg = cooperative_groups;
namespace pg8 {
#define PG8_LAS __attribute__((address_space(3)))
typedef unsigned short bf16_t;
typedef short bf16x8 __attribute__((ext_vector_type(8)));
typedef float f32x4 __attribute__((ext_vector_type(4)));
typedef unsigned u32x4 __attribute__((ext_vector_type(4)));
constexpr int BM = 256, BK = 64, HALF = 128, HTB = HALF * BK * 2  , STAGE_BYTES = 8 * HTB, NXCD = 8, WGM = 8;

__host__ __device__ __forceinline__ int lds_byte(int r, int c) { const int st = (r >> 4) * 2 + (c >> 5), rr = r & 15, cc = c & 31, ob = rr * 64 + cc * 2; return st * 1024 + (ob ^ (((ob >> 9) & 1) << 5)); }
__host__ __device__ __forceinline__ void stage_rc(int b, int& R, int& C) { const int st = b / 1024, sb = b % 1024, swz = sb ^ (((sb >> 9) & 1) << 5); R = (st >> 1) * 16 + swz / 64; C = (st & 1) * 32 + (swz % 64) / 2; }
__host__ __device__ __forceinline__ int perm32(int rho) { const int n = rho >> 4, i = rho & 15; return 8 * (i >> 2) + 4 * n + (i & 3); }

struct Unit { int pm, pn; };
struct Gemm { const bf16_t* A; const bf16_t* Bt; int M, N, K; };

struct StaticOrder {
    int nM, nN, nwg, G, c;
    __host__ __device__ void init(int M, int N, int G_, int c_) { nM = M / BM; nN = N / BM; nwg = nM * nN; G = G_; c = c_; }
    __host__ __device__ bool next(int i, Unit& u) const {
        const long L = (long)i * G + c; if (L >= nwg) return false;
        int wgid = (int)L; { const int q = nwg / NXCD, r = nwg % NXCD, xcd = wgid % NXCD, off = wgid / NXCD; wgid = (xcd < r ? xcd * (q + 1) : r * (q + 1) + (xcd - r) * q) + off; }
        const int nig = WGM * nN, gid = wgid / nig, fm = gid * WGM, gsz = (nM - fm) < WGM ? (nM - fm) : WGM;
        u.pm = fm + ((wgid % nig) % gsz); u.pn = (wgid % nig) / gsz; return true;
    }
    __device__ __forceinline__ void a_ready(const Unit&) const {}
    __device__ __forceinline__ void done(const Unit&) const {}
};

typedef float f32x2_t __attribute__((ext_vector_type(2))); typedef __bf16 bf16x2_t __attribute__((ext_vector_type(2)));
__device__ __forceinline__ unsigned cvt_pk_bf16(float lo, float hi) { f32x2_t v = {lo, hi}; bf16x2_t b = __builtin_convertvector(v, bf16x2_t); return __builtin_bit_cast(unsigned, b); }
typedef float f32x2 __attribute__((ext_vector_type(2)));
template <class Epi, class Sched, bool ALIGN_EPI = false, bool SP2 = false>
__device__ __forceinline__ void gemm_phase(PG8_LAS unsigned char* lds, const Gemm g, const Sched& S, const Epi& E) {
    int tid_ = threadIdx.x; asm volatile("" : "+v"(tid_));
    const int tid = tid_, wid = __builtin_amdgcn_readfirstlane(tid >> 6), lane = tid & 63, wr = wid >> 2, wc = wid & 3, fr = lane & 15, fq = lane >> 4;
    const int K = g.K, nt = K / BK;
    unsigned voffA[2], voffB[2];
#pragma unroll
    for (int i = 0; i < 2; ++i) { int R, C; stage_rc(tid * 16 + i * 8192, R, C); const int Rb = Epi::PERM ? ((R & ~31) + perm32(R & 31)) : R;
        voffA[i] = (unsigned)(R * K + C) * 2u; voffB[i] = (unsigned)(Rb * K + C) * 2u; }
    const size_t kstep = (size_t)(BK * 2);
    const size_t hstep = (size_t)HALF * K * 2;
    const size_t tstep = 2 * hstep;
    const unsigned ldsw = (unsigned)wid * 1024u;
    const int aoff = lds_byte(wr * 64 + fr, fq * 8), boff = lds_byte(wc * 32 + fr, fq * 8);
#define PG8_SA(b, h) (((b) * 2 + (h)) * HTB)
#define PG8_SB(b, h) ((4 + (b) * 2 + (h)) * HTB)
#define PG8_STAGE(bufoff, gbase, voff) do { _Pragma("unroll") for (int _i = 0; _i < 2; ++_i) \
        __builtin_amdgcn_global_load_lds((const unsigned*)((const char*)(gbase) + (voff)[_i]), (PG8_LAS unsigned*)(lds + (bufoff) + ldsw + _i * 8192), 16, 0, 0); } while (0)
#define PG8_LDA(dst, b, h) do { _Pragma("unroll") for (int m = 0; m < 4; ++m) _Pragma("unroll") for (int k = 0; k < 2; ++k) dst[m][k] = *(const PG8_LAS bf16x8*)(lds + PG8_SA(b, h) + aoff + m * 2048 + k * 1024); } while (0)
#define PG8_LDB(dst, b, h) do { _Pragma("unroll") for (int n = 0; n < 2; ++n) _Pragma("unroll") for (int k = 0; k < 2; ++k) dst[n][k] = *(const PG8_LAS bf16x8*)(lds + PG8_SB(b, h) + boff + n * 2048 + k * 1024); } while (0)
#define PG8_MMA(ai, bj, At, Bt) do { __builtin_amdgcn_s_setprio(1); _Pragma("unroll") for (int m = 0; m < 4; ++m) _Pragma("unroll") for (int n = 0; n < 2; ++n) _Pragma("unroll") for (int k = 0; k < 2; ++k) \
        acc[ai][bj][m][n] = __builtin_amdgcn_mfma_f32_16x16x32_bf16(Bt[n][k], At[m][k], acc[ai][bj][m][n], 0, 0, 0); __builtin_amdgcn_s_setprio(0); } while (0)
#define PG8_WAIT_V(n) asm volatile("s_waitcnt vmcnt(" #n ")" ::: "memory")
#define PG8_WAIT_L(n) asm volatile("s_waitcnt lgkmcnt(" #n ")" ::: "memory")
#define PG8_BAR __builtin_amdgcn_s_barrier()
#define PG8_SCHED __builtin_amdgcn_sched_barrier(0)
    Unit cur, nxt; int ui = 0;
    if (!S.next(0, cur)) return;
    f32x4 acc[2][2][4][2];
#pragma unroll
    for (int a = 0; a < 2; ++a)
#pragma unroll
        for (int b = 0; b < 2; ++b)
#pragma unroll
            for (int m = 0; m < 4; ++m)
#pragma unroll
                for (int n = 0; n < 2; ++n) acc[a][b][m][n] = (f32x4){0.f, 0.f, 0.f, 0.f};
    bf16x8 At[4][2], B0[2][2], B1[2][2];
    const char* cA = (const char*)g.A + (size_t)cur.pm * tstep; const char* cB = (const char*)g.Bt + (size_t)cur.pn * tstep;
    S.a_ready(cur);
    if constexpr (SP2) {
        PG8_STAGE(PG8_SB(0, 0), cB, voffB); PG8_STAGE(PG8_SB(0, 1), cB + hstep, voffB); PG8_STAGE(PG8_SA(0, 0), cA, voffA); PG8_STAGE(PG8_SA(0, 1), cA + hstep, voffA);
        if (wr == 1) PG8_BAR;
        PG8_WAIT_V(2); PG8_BAR;
        PG8_STAGE(PG8_SB(1, 0), cB + kstep, voffB); PG8_STAGE(PG8_SA(1, 0), cA + kstep, voffA); PG8_STAGE(PG8_SB(1, 1), cB + hstep + kstep, voffB);
        PG8_WAIT_V(6); PG8_BAR;
    } else {
        PG8_STAGE(PG8_SB(0, 0), cB, voffB); PG8_STAGE(PG8_SA(0, 0), cA, voffA); PG8_STAGE(PG8_SB(0, 1), cB + hstep, voffB); PG8_STAGE(PG8_SA(0, 1), cA + hstep, voffA);
        if (wr == 1) PG8_BAR;
        PG8_WAIT_V(4); PG8_BAR;
        PG8_STAGE(PG8_SB(1, 0), cB + kstep, voffB); PG8_STAGE(PG8_SA(1, 0), cA + kstep, voffA); PG8_STAGE(PG8_SB(1, 1), cB + hstep + kstep, voffB);
        PG8_WAIT_V(6); PG8_BAR;
    }
    for (;;) {
        const bool has_next = S.next(ui + 1, nxt);
        const char* nA = has_next ? (const char*)g.A + (size_t)nxt.pm * tstep : cA; const char* nB = has_next ? (const char*)g.Bt + (size_t)nxt.pn * tstep : cB;
#pragma unroll 1
        for (int t = 0; t < nt; t += 2) {
            const bool last = (t == nt - 2);
            const char* a1 = cA + (size_t)(t + 1) * kstep;
            const char* a2 = last ? nA : cA + (size_t)(t + 2) * kstep; const char* b2 = last ? nB : cB + (size_t)(t + 2) * kstep;
            const char* a3 = a2 + kstep; const char* b3 = b2 + kstep;
            if (last && has_next) S.a_ready(nxt);
            if constexpr (SP2) {
            PG8_LDB(B0, 0, 0); PG8_LDB(B1, 0, 1); PG8_SCHED; PG8_LDA(At, 0, 0); PG8_STAGE(PG8_SA(1, 1), a1 + hstep, voffA);
            PG8_WAIT_V(8); PG8_WAIT_L(0); PG8_BAR; PG8_MMA(0, 0, At, B0); PG8_MMA(0, 1, At, B1); PG8_BAR; PG8_SCHED;
            PG8_LDA(At, 0, 1); PG8_STAGE(PG8_SB(0, 0), b2, voffB); PG8_STAGE(PG8_SB(0, 1), b2 + hstep, voffB); PG8_STAGE(PG8_SA(0, 0), a2, voffA);
            PG8_WAIT_V(8); PG8_WAIT_L(0); PG8_BAR; PG8_MMA(1, 0, At, B0); PG8_MMA(1, 1, At, B1); PG8_BAR; PG8_SCHED;
            PG8_LDB(B0, 1, 0); PG8_LDB(B1, 1, 1); PG8_SCHED; PG8_LDA(At, 1, 0); PG8_STAGE(PG8_SA(0, 1), a2 + hstep, voffA);
            PG8_WAIT_V(8); PG8_WAIT_L(0); PG8_BAR; PG8_MMA(0, 0, At, B0); PG8_MMA(0, 1, At, B1); PG8_BAR; PG8_SCHED;
            PG8_LDA(At, 1, 1); PG8_STAGE(PG8_SB(1, 0), b3, voffB); PG8_STAGE(PG8_SB(1, 1), b3 + hstep, voffB); PG8_STAGE(PG8_SA(1, 0), a3, voffA);
            PG8_WAIT_V(8); PG8_WAIT_L(0); PG8_BAR; PG8_MMA(1, 0, At, B0); PG8_MMA(1, 1, At, B1); PG8_BAR; PG8_SCHED;
            } else {
            PG8_LDB(B0, 0, 0); PG8_SCHED; PG8_LDA(At, 0, 0); PG8_STAGE(PG8_SA(1, 1), a1 + hstep, voffA);
            PG8_WAIT_L(8); PG8_BAR; PG8_WAIT_L(0); PG8_MMA(0, 0, At, B0); PG8_BAR; PG8_SCHED;
            PG8_LDB(B1, 0, 1); PG8_STAGE(PG8_SB(0, 0), b2, voffB);
            PG8_BAR; PG8_WAIT_L(0); PG8_MMA(0, 1, At, B1); PG8_BAR;
            PG8_LDA(At, 0, 1); PG8_STAGE(PG8_SA(0, 0), a2, voffA);
            PG8_BAR; PG8_WAIT_L(0); PG8_MMA(1, 0, At, B0); PG8_BAR; PG8_SCHED;
            PG8_STAGE(PG8_SB(0, 1), b2 + hstep, voffB);
            PG8_WAIT_V(6); PG8_BAR; PG8_MMA(1, 1, At, B1); PG8_BAR;
            PG8_LDB(B0, 1, 0); PG8_SCHED; PG8_LDA(At, 1, 0); PG8_STAGE(PG8_SA(0, 1), a2 + hstep, voffA);
            PG8_WAIT_L(8); PG8_BAR; PG8_WAIT_L(0); PG8_MMA(0, 0, At, B0); PG8_BAR; PG8_SCHED;
            PG8_LDB(B1, 1, 1); PG8_STAGE(PG8_SB(1, 0), b3, voffB);
            PG8_BAR; PG8_WAIT_L(0); PG8_MMA(0, 1, At, B1); PG8_BAR;
            PG8_LDA(At, 1, 1); PG8_STAGE(PG8_SA(1, 0), a3, voffA);
            PG8_BAR; PG8_WAIT_L(0); PG8_MMA(1, 0, At, B0); PG8_BAR; PG8_SCHED;
            PG8_STAGE(PG8_SB(1, 1), b3 + hstep, voffB);
            PG8_WAIT_V(6); PG8_BAR; PG8_MMA(1, 1, At, B1); PG8_BAR;
            }
        }
        if constexpr (ALIGN_EPI) { if (wr == 0) PG8_BAR; }
        if constexpr (!Epi::AFTER_DRAIN) { E(acc, cur, wr, wc, fr, fq); S.done(cur); }
        if (!has_next) break;
#pragma unroll
        for (int a = 0; a < 2; ++a)
#pragma unroll
            for (int b = 0; b < 2; ++b)
#pragma unroll
                for (int m = 0; m < 4; ++m)
#pragma unroll
                    for (int n = 0; n < 2; ++n) acc[a][b][m][n] = (f32x4){0.f, 0.f, 0.f, 0.f};
        cur = nxt; cA = nA; cB = nB; ++ui;
        if constexpr (ALIGN_EPI) { if (wr == 1) PG8_BAR; }
    }
    PG8_WAIT_V(0);
    if constexpr (!ALIGN_EPI) { if (wr == 0) PG8_BAR; }
    PG8_BAR;
    if constexpr (Epi::AFTER_DRAIN) { E.fused(acc, cur, wr, wc, fr, fq, lds, wid, lane); S.done(cur); }
#undef PG8_SA
#undef PG8_SB
#undef PG8_STAGE
#undef PG8_LDA
#undef PG8_LDB
#undef PG8_MMA
#undef PG8_WAIT_V
#undef PG8_WAIT_L
#undef PG8_BAR
#undef PG8_SCHED
}
}

#ifndef PH_MASK
#define PH_MASK 0xFFFF
#endif
#define PH(k) ((PH_MASK >> (k)) & 1)
constexpr int NB = 2, SEQ = 8192, M = NB * SEQ, D = 1024;
constexpr int N1 = 4352;
constexpr int FF = 2816;
constexpr float EPS = 1e-6f;
constexpr float LOG2E = 1.4426950408889634f;
constexpr float QS_M = 0.10206207261596577f * LOG2E;
constexpr float QS_D = 0.125f * LOG2E;
constexpr float LAMBDA_INIT = 0.2f;

constexpr size_t MiB = 1u << 20;
constexpr size_t WS_SS = 0;
constexpr size_t WS_TAB = 1 * MiB;
constexpr size_t WS_W1 = 4 * MiB, WS_W2A = 13 * MiB, WS_W2B = 14 * MiB, WS_W3A = 15 * MiB, WS_W3B = 16 * MiB, WS_W4 = 17 * MiB, WS_W5 = 19 * MiB, WS_W6 = 30 * MiB;
constexpr size_t WS_XN = 36 * MiB, WS_QL = 68 * MiB, WS_KVL = 80 * MiB;
constexpr size_t WS_OM = 36 * MiB, WS_ODR = 52 * MiB;
constexpr size_t WS_QD = 88 * MiB, WS_ODN = 88 * MiB;
constexpr size_t WS_KD = 104 * MiB, WS_VDT = 120 * MiB, WS_MERGED = 104 * MiB;
constexpr size_t WS_QM = 136 * MiB, WS_KM = 160 * MiB, WS_VMT = 184 * MiB, WS_TMP = 136 * MiB;
constexpr size_t WS_X1B = 200 * MiB;
constexpr size_t WS_H = 36 * MiB;
constexpr size_t WS_PART = 232 * MiB;
constexpr size_t WS_END = 236 * MiB;

constexpr int LDS_BYTES = 147456;

#define LAS __attribute__((address_space(3)))
typedef unsigned short bf16;
typedef unsigned v4u __attribute__((ext_vector_type(4)));
typedef unsigned v2u __attribute__((ext_vector_type(2)));
typedef float f32x4 __attribute__((ext_vector_type(4)));
typedef float f32x16 __attribute__((ext_vector_type(16)));
typedef short bf16x8 __attribute__((ext_vector_type(8)));
using pg8::cvt_pk_bf16;
#define LDS_WAIT() asm volatile("s_waitcnt lgkmcnt(0)" ::: "memory")
__device__ __forceinline__ unsigned f2bf(float f) { unsigned u = __builtin_bit_cast(unsigned, f); return (u + 0x7fffu + ((u >> 16) & 1u)) >> 16; }
__device__ __forceinline__ unsigned pk2(float lo, float hi) { return f2bf(lo) | (f2bf(hi) << 16); }
__device__ __forceinline__ float bf2f(unsigned h) { return __builtin_bit_cast(float, h << 16); }
__device__ __forceinline__ float wave_sum(float v) {
#pragma unroll
    for (int o = 1; o < 64; o <<= 1) v += __shfl_xor(v, o);
    return v;
}
__device__ __forceinline__ int p16(int k) { return ((k >> 2) & 1) * 8 + (k >> 3) * 4 + (k & 3); }
__device__ __forceinline__ float sigmoidf_(float v) { return __builtin_amdgcn_rcpf(1.f + __builtin_amdgcn_exp2f(-v * LOG2E)); }
__device__ __forceinline__ v2u pack4(f32x4 v) { v2u r; r.x = cvt_pk_bf16(v[0], v[1]); r.y = cvt_pk_bf16(v[2], v[3]); return r; }
__device__ __forceinline__ v4u pack8(f32x4 a, f32x4 b) { v4u r; r.x = cvt_pk_bf16(a[0], a[1]); r.y = cvt_pk_bf16(a[2], a[3]); r.z = cvt_pk_bf16(b[0], b[1]); r.w = cvt_pk_bf16(b[2], b[3]); return r; }

using pg8::Unit;
struct EpiInProj {
    static constexpr bool PERM = true, AFTER_DRAIN = false;
    bf16 *Qd, *Kd, *VdT, *GATES, *QL, *KVL, *Km; const float *bgate, *tdc, *tds, *tmc, *tms; float *ssq, *sskv;
    __device__ __forceinline__ void operator()(const f32x4 (&acc)[2][2][4][2], const Unit& u, int wr, int wc, int fr, int fq) const {
        const int pn = u.pn; const int row0 = u.pm * 256 + wr * 64 + fr;
        if (pn < 4) {
            bf16* dst = pn < 2 ? Qd : Kd; const float sc = pn < 2 ? QS_D : 1.f; const int cb = (pn & 1) * 256 + wc * 32 + 8 * fq;
            const bool rope = (wc & 1) == 0;
#pragma unroll
            for (int ai = 0; ai < 2; ++ai)
#pragma unroll
                for (int m = 0; m < 4; ++m) {
                    const int row = row0 + ai * 128 + m * 16;
                    f32x4 c0 = {1.f, 1.f, 1.f, 1.f}, c1 = c0, s0 = {0.f, 0.f, 0.f, 0.f}, s1 = s0;
                    if (rope) { c0 = *(const f32x4*)(tdc + (size_t)row * 8); c1 = *(const f32x4*)(tdc + (size_t)row * 8 + 4); s0 = *(const f32x4*)(tds + (size_t)row * 8); s1 = *(const f32x4*)(tds + (size_t)row * 8 + 4); }
#pragma unroll
                    for (int bj = 0; bj < 2; ++bj) {
                        f32x4 v0 = acc[ai][bj][m][0], v1 = acc[ai][bj][m][1];
                        if (rope) {
#pragma unroll
                            for (int j = 0; j < 4; ++j) {
                                const float p0 = __shfl_xor(v0[j], 16), p1 = __shfl_xor(v1[j], 16);
                                if (fq == 0) { v0[j] = v0[j] * c0[j] - p0 * s0[j]; v1[j] = v1[j] * c1[j] - p1 * s1[j]; }
                                else if (fq == 1) { v0[j] = v0[j] * c0[j] + p0 * s0[j]; v1[j] = v1[j] * c1[j] + p1 * s1[j]; }
                            }
                        }
                        v0 = v0 * sc; v1 = v1 * sc;
                        *(v4u*)(dst + (size_t)row * 512 + cb + bj * 128) = pack8(v0, v1);
                    }
                }
        } else if (pn < 6) {
#pragma unroll
            for (int ai = 0; ai < 2; ++ai)
#pragma unroll
                for (int m = 0; m < 4; ++m) {
                    const int row = row0 + ai * 128 + m * 16; const int b = row >> 13, pos = row & (SEQ - 1), pp = (pos & ~15) | p16(pos & 15);
#pragma unroll
                    for (int bj = 0; bj < 2; ++bj) {
                        const int h = (pn - 4) * 2 + bj;
                        bf16* base = VdT + ((size_t)((b * 4 + h) * 128 + wc * 32 + 8 * fq)) * SEQ + pp;
#pragma unroll
                        for (int n = 0; n < 2; ++n)
#pragma unroll
                            for (int j = 0; j < 4; ++j) base[(size_t)(4 * n + j) * SEQ] = (bf16)f2bf(acc[ai][bj][m][n][j]);
                    }
                }
        } else if (pn < 14) {
            const int cb = (pn - 6) * 256 + wc * 32 + 8 * fq;
            f32x4 bv[2][2];
#pragma unroll
            for (int bj = 0; bj < 2; ++bj) { bv[bj][0] = *(const f32x4*)(bgate + cb + bj * 128); bv[bj][1] = *(const f32x4*)(bgate + cb + bj * 128 + 4); }
#pragma unroll
            for (int ai = 0; ai < 2; ++ai)
#pragma unroll
                for (int m = 0; m < 4; ++m) {
                    const int row = row0 + ai * 128 + m * 16;
#pragma unroll
                    for (int bj = 0; bj < 2; ++bj) {
                        f32x4 v0 = acc[ai][bj][m][0] + bv[bj][0], v1 = acc[ai][bj][m][1] + bv[bj][1];
#pragma unroll
                        for (int j = 0; j < 4; ++j) { v0[j] = sigmoidf_(v0[j]); v1[j] = sigmoidf_(v1[j]); }
                        *(v4u*)(GATES + (size_t)row * 2048 + cb + bj * 128) = pack8(v0, v1);
                    }
                }
        } else {
#pragma unroll
            for (int bj = 0; bj < 2; ++bj) {
                const int hh = 2 * (pn - 14) + bj;
                if (hh <= 4) {
                    bf16* dst; int ld, cb; float* ss; int sld;
                    if (hh <= 2) { dst = QL; ld = 384; cb = hh * 128; ss = ssq + hh * 4 + wc; sld = 16; } else { dst = KVL; ld = 256; cb = (hh - 3) * 128; ss = sskv + (hh - 3) * 4 + wc; sld = 8; }
                    cb += wc * 32 + 8 * fq;
#pragma unroll
                    for (int ai = 0; ai < 2; ++ai)
#pragma unroll
                        for (int m = 0; m < 4; ++m) {
                            const int row = row0 + ai * 128 + m * 16;
                            const f32x4 v0 = acc[ai][bj][m][0], v1 = acc[ai][bj][m][1];
                            float s = (v0[0] * v0[0] + v0[1] * v0[1]) + (v0[2] * v0[2] + v0[3] * v0[3]) + (v1[0] * v1[0] + v1[1] * v1[1]) + (v1[2] * v1[2] + v1[3] * v1[3]);
                            s += __shfl_xor(s, 16); s += __shfl_xor(s, 32);
                            if (fq == 0) ss[(size_t)row * sld] = s;
                            *(v4u*)(dst + (size_t)row * ld + cb) = pack8(v0, v1);
                        }
                } else if (wc == 0) {
#pragma unroll
                    for (int ai = 0; ai < 2; ++ai)
#pragma unroll
                        for (int m = 0; m < 4; ++m) {
                            const int row = row0 + ai * 128 + m * 16;
                            const f32x4 c0 = *(const f32x4*)(tmc + (size_t)row * 16 + 8 * (fq & 1)), c1 = *(const f32x4*)(tmc + (size_t)row * 16 + 8 * (fq & 1) + 4);
                            const f32x4 s0 = *(const f32x4*)(tms + (size_t)row * 16 + 8 * (fq & 1)), s1 = *(const f32x4*)(tms + (size_t)row * 16 + 8 * (fq & 1) + 4);
                            f32x4 v0 = acc[ai][bj][m][0], v1 = acc[ai][bj][m][1];
#pragma unroll
                            for (int j = 0; j < 4; ++j) {
                                const float p0 = __shfl_xor(v0[j], 32), p1 = __shfl_xor(v1[j], 32);
                                if (fq < 2) { v0[j] = v0[j] * c0[j] - p0 * s0[j]; v1[j] = v1[j] * c1[j] - p1 * s1[j]; }
                                else { v0[j] = v0[j] * c0[j] + p0 * s0[j]; v1[j] = v1[j] * c1[j] + p1 * s1[j]; }
                            }
                            const v4u w = pack8(v0, v1);
#pragma unroll
                            for (int h = 0; h < 8; ++h) *(v4u*)(Km + (size_t)row * 768 + h * 96 + 64 + 8 * fq) = w;
                        }
                }
            }
        }
    }
};
struct EpiQup {
    static constexpr bool PERM = false, AFTER_DRAIN = false;
    bf16* Qm; const float *ssq, *tmc, *tms;
    __device__ __forceinline__ void operator()(const f32x4 (&acc)[2][2][4][2], const Unit& u, int wr, int wc, int fr, int fq) const {
        const int row0 = u.pm * 256 + wr * 64 + fr;
#pragma unroll
        for (int ai = 0; ai < 2; ++ai)
#pragma unroll
            for (int m = 0; m < 4; ++m) {
                const int row = row0 + ai * 128 + m * 16;
                const f32x4 pa = *(const f32x4*)(ssq + (size_t)row * 16), pb = *(const f32x4*)(ssq + (size_t)row * 16 + 4), pc = *(const f32x4*)(ssq + (size_t)row * 16 + 8);
                const float sq = ((pa[0] + pa[1]) + (pa[2] + pa[3])) + ((pb[0] + pb[1]) + (pb[2] + pb[3])) + ((pc[0] + pc[1]) + (pc[2] + pc[3]));
                const float rs = rsqrtf(sq * (1.f / 384.f) + EPS) * QS_M;
#pragma unroll
                for (int bj = 0; bj < 2; ++bj) {
                    const int gi = 8 * u.pn + 4 * bj + wc, part = gi % 3;
                    f32x4 v0 = acc[ai][bj][m][0] * rs, v1 = acc[ai][bj][m][1] * rs;
                    if (part == 2) {
                        const f32x4 c = *(const f32x4*)(tmc + (size_t)row * 16 + 4 * fq), s = *(const f32x4*)(tms + (size_t)row * 16 + 4 * fq);
                        const f32x4 o0 = v0 * c - v1 * s, o1 = v1 * c + v0 * s; v0 = o0; v1 = o1;
                    }
                    bf16* p = Qm + (size_t)row * 768 + 32 * gi + 4 * fq;
                    *(v2u*)p = pack4(v0); *(v2u*)(p + 16) = pack4(v1);
                }
                asm volatile("" ::: "memory");
            }
    }
};
struct EpiKVup {
    static constexpr bool PERM = false, AFTER_DRAIN = false;
    bf16 *Km, *VmT; const float* sskv;
    __device__ __forceinline__ void operator()(const f32x4 (&acc)[2][2][4][2], const Unit& u, int wr, int wc, int fr, int fq) const {
        const int row0 = u.pm * 256 + wr * 64 + fr;
#pragma unroll
        for (int ai = 0; ai < 2; ++ai)
#pragma unroll
            for (int m = 0; m < 4; ++m) {
                const int row = row0 + ai * 128 + m * 16; const int b = row >> 13, pos = row & (SEQ - 1), pp = (pos & ~15) | p16(pos & 15);
                const f32x4 pa = *(const f32x4*)(sskv + (size_t)row * 8), pb = *(const f32x4*)(sskv + (size_t)row * 8 + 4);
                const float rs = rsqrtf((((pa[0] + pa[1]) + (pa[2] + pa[3])) + ((pb[0] + pb[1]) + (pb[2] + pb[3]))) * (1.f / 256.f) + EPS);
#pragma unroll
                for (int bj = 0; bj < 2; ++bj) {
                    const int head = 2 * u.pn + bj;
                    const f32x4 v0 = acc[ai][bj][m][0] * rs, v1 = acc[ai][bj][m][1] * rs;
                    if (wc < 2) {
                        bf16* p = Km + (size_t)row * 768 + head * 96 + 32 * wc + 4 * fq;
                        *(v2u*)p = pack4(v0); *(v2u*)(p + 16) = pack4(v1);
                    } else {
                        bf16* base = VmT + ((size_t)((b * 8 + head) * 64 + 32 * (wc - 2) + 4 * fq)) * SEQ + pp;
#pragma unroll
                        for (int j = 0; j < 4; ++j) { base[(size_t)j * SEQ] = (bf16)f2bf(v0[j]); base[(size_t)(16 + j) * SEQ] = (bf16)f2bf(v1[j]); }
                    }
                }
                asm volatile("" ::: "memory");
            }
    }
};
template <int STEP> struct EpiBranch {
    static constexpr bool PERM = false, AFTER_DRAIN = false;
    const bf16* GATES; float* TMP; bf16* MERGED;
    __device__ __forceinline__ void operator()(const f32x4 (&acc)[2][2][4][2], const Unit& u, int wr, int wc, int fr, int fq) const {
        const int row0 = u.pm * 256 + wr * 64 + fr, col0 = u.pn * 256 + wc * 32 + 4 * fq;
#pragma unroll
        for (int ai = 0; ai < 2; ++ai)
#pragma unroll
            for (int m = 0; m < 4; ++m) {
                const int row = row0 + ai * 128 + m * 16;
#pragma unroll
                for (int bj = 0; bj < 2; ++bj)
#pragma unroll
                    for (int n = 0; n < 2; ++n) {
                        const int col = col0 + bj * 128 + n * 16;
                        const v2u gw = *(const v2u*)(GATES + (size_t)row * 2048 + STEP * 1024 + col);
                        const f32x4 g = {bf2f(gw.x & 0xffffu), bf2f(gw.x >> 16), bf2f(gw.y & 0xffffu), bf2f(gw.y >> 16)};
                        float* tp = TMP + (size_t)row * 1024 + col;
                        if (STEP == 0) *(f32x4*)tp = acc[ai][bj][m][n] * g;
                        else { const f32x4 t = *(const f32x4*)tp; *(v2u*)(MERGED + (size_t)row * 1024 + col) = pack4(t + acc[ai][bj][m][n] * g); }
                    }
            }
    }
};
struct EpiRes {
    static constexpr bool PERM = false, AFTER_DRAIN = false;
    const float* base; float* out; bf16* outb; float* ss;
    __device__ __forceinline__ void operator()(const f32x4 (&acc)[2][2][4][2], const Unit& u, int wr, int wc, int fr, int fq) const {
        const int row0 = u.pm * 256 + wr * 64 + fr, col0 = u.pn * 256 + wc * 32 + 4 * fq;
#pragma unroll
        for (int ai = 0; ai < 2; ++ai)
#pragma unroll
            for (int m = 0; m < 4; ++m) {
                const int row = row0 + ai * 128 + m * 16; float s = 0.f;
#pragma unroll
                for (int bj = 0; bj < 2; ++bj)
#pragma unroll
                    for (int n = 0; n < 2; ++n) {
                        const size_t off = (size_t)row * 1024 + col0 + bj * 128 + n * 16;
                        const f32x4 v = *(const f32x4*)(base + off) + acc[ai][bj][m][n];
                        s += (v[0] * v[0] + v[1] * v[1]) + (v[2] * v[2] + v[3] * v[3]);
                        *(f32x4*)(out + off) = v;
                        if (outb) *(v2u*)(outb + off) = pack4(v);
                    }
                s += __shfl_xor(s, 16); s += __shfl_xor(s, 32);
                if (fq == 0) ss[(size_t)row * 16 + u.pn * 4 + wc] = s;
            }
    }
};
struct EpiSwiglu {
    static constexpr bool PERM = true, AFTER_DRAIN = false;
    bf16* H; const float* ss1;
    __device__ __forceinline__ void operator()(const f32x4 (&acc)[2][2][4][2], const Unit& u, int wr, int wc, int fr, int fq) const {
        const int row0 = u.pm * 256 + wr * 64 + fr, col0 = u.pn * 128 + wc * 32 + 8 * fq;
#pragma unroll
        for (int ai = 0; ai < 2; ++ai)
#pragma unroll
            for (int m = 0; m < 4; ++m) {
                const int row = row0 + ai * 128 + m * 16;
                float sq = 0.f;
#pragma unroll
                for (int k = 0; k < 4; ++k) { const f32x4 p = *(const f32x4*)(ss1 + (size_t)row * 16 + 4 * k); sq += (p[0] + p[1]) + (p[2] + p[3]); }
                const float rs = rsqrtf(sq * (1.f / 1024.f) + EPS);
                f32x4 o[2];
#pragma unroll
                for (int n = 0; n < 2; ++n) {
                    const f32x4 g = acc[ai][0][m][n] * rs, up = acc[ai][1][m][n] * rs;
#pragma unroll
                    for (int j = 0; j < 4; ++j) o[n][j] = g[j] * sigmoidf_(g[j]) * up[j];
                }
                *(v4u*)(H + (size_t)row * FF + col0) = pack8(o[0], o[1]);
            }
    }
};

template <int DK, int DV>
__device__ __forceinline__ void attn_unit(LAS unsigned char* lds, const bf16* Qp, int ldq, const bf16* Kp, int ldk, const bf16* VTp, bf16* Op, int ldo, int qb) {
    constexpr int KC = DK / 8, KP = DK * 2 + 16, VP = 144, KTB = 64 * KP, BUF = KTB + DV * VP;
    constexpr int KCH = 64 * KC, VCH = DV * 8, NKL = (KCH + 511) / 512, NVL = VCH / 512, NDB = DV / 32, NQC = DK / 16;
    int tid_ = threadIdx.x; asm volatile("" : "+v"(tid_));
    const int tid = tid_, lane = tid & 63, w = __builtin_amdgcn_readfirstlane(tid >> 6), q = lane & 31, hi = lane >> 5;
    const bool grpB = w >= 4;
    const int q0 = qb * 256, NT = 4 * (qb + 1);
    LAS bf16x8* qsp = (LAS bf16x8*)(lds + 3 * BUF + w * (NQC * 1024)) + lane;
    { const bf16* qrow = Qp + (size_t)(q0 + 32 * w + q) * ldq + 8 * hi;
#pragma unroll
      for (int c = 0; c < NQC; ++c) qsp[c * 64] = *(const bf16x8*)(qrow + 16 * c); }
    v4u kra[NKL], vra[NVL], krb[NKL], vrb[NVL];
#define ATT_LOAD(t, KR, VR) do { \
    _Pragma("unroll") for (int i_ = 0; i_ < NKL; ++i_) { int id_ = tid + 512 * i_; if ((KCH % 512 != 0) && id_ >= KCH) id_ -= 512; { const int r_ = id_ / KC, c_ = id_ % KC; KR[i_] = *(const v4u*)(Kp + (size_t)(64 * (t) + r_) * ldk + c_ * 8); } } \
    _Pragma("unroll") for (int i_ = 0; i_ < NVL; ++i_) { const int id_ = tid + 512 * i_; const int d_ = id_ >> 3, c_ = id_ & 7; VR[i_] = *(const v4u*)(VTp + (size_t)d_ * SEQ + 64 * (t) + c_ * 8); } } while (0)
#define ATT_STORE(boff, KR, VR) do { \
    _Pragma("unroll") for (int i_ = 0; i_ < NKL; ++i_) { int id_ = tid + 512 * i_; if ((KCH % 512 != 0) && id_ >= KCH) id_ -= 512; { const int r_ = id_ / KC, c_ = id_ % KC; *(LAS v4u*)(lds + (boff) + r_ * KP + c_ * 16) = KR[i_]; } } \
    _Pragma("unroll") for (int i_ = 0; i_ < NVL; ++i_) { const int id_ = tid + 512 * i_; const int d_ = id_ >> 3, c_ = id_ & 7; *(LAS v4u*)(lds + (boff) + KTB + d_ * VP + c_ * 16) = VR[i_]; } } while (0)
#define ATT_QK(boff) do { \
    const LAS unsigned char* kb_ = lds + (boff) + q * KP + hi * 16; \
    _Pragma("unroll") for (int c = 0; c < NQC; ++c) { \
        const bf16x8 a0 = *(const LAS bf16x8*)(kb_ + c * 32), a1 = *(const LAS bf16x8*)(kb_ + 32 * KP + c * 32), qc = qsp[c * 64]; \
        if (c == 0) { s0 = __builtin_amdgcn_mfma_f32_32x32x16_bf16(a0, qc, zacc, 0, 0, 0); s1 = __builtin_amdgcn_mfma_f32_32x32x16_bf16(a1, qc, zacc, 0, 0, 0); } \
        else { s0 = __builtin_amdgcn_mfma_f32_32x32x16_bf16(a0, qc, s0, 0, 0, 0); s1 = __builtin_amdgcn_mfma_f32_32x32x16_bf16(a1, qc, s1, 0, 0, 0); } } } while (0)
#define ATT_BAR() do { asm volatile("s_waitcnt lgkmcnt(0)" ::: "memory"); __builtin_amdgcn_s_barrier(); asm volatile("" ::: "memory"); } while (0)
#define ATT_STEP(t, KRL, VRL, KRS, VRS) do { \
    const int t_ = (t); \
    { const int tl_ = t_ + 3 < NT ? t_ + 3 : NT - 1; ATT_LOAD(tl_, KRL, VRL); }     \
    const int tb = t_ - (NT - 4); \
    const bool act = tb < 0 || 64 * tb <= 32 * w + 31, actn = (t_ + 1 < NT) && (tb + 1 < 0 || 64 * (tb + 1) <= 32 * w + 31); \
    v4u pw[4]; \
    if (act) { \
        if (tb >= 0) { const int qrel = 32 * w + q, kb0 = 64 * tb + 4 * hi; \
            _Pragma("unroll") for (int r = 0; r < 16; ++r) { const int kv = kb0 + (r & 3) + 8 * (r >> 2); if (kv > qrel) s0[r] = -INFINITY; if (kv + 32 > qrel) s1[r] = -INFINITY; } } \
        float mxa = fmaxf(fmaxf(s0[0], s0[1]), s0[2]), mxb = fmaxf(fmaxf(s1[0], s1[1]), s1[2]); \
        mxa = fmaxf(fmaxf(mxa, s0[3]), s0[4]); mxb = fmaxf(fmaxf(mxb, s1[3]), s1[4]); \
        _Pragma("unroll") for (int r = 5; r < 15; r += 2) { mxa = fmaxf(fmaxf(mxa, s0[r]), s0[r + 1]); mxb = fmaxf(fmaxf(mxb, s1[r]), s1[r + 1]); } \
        float mx = fmaxf(fmaxf(mxa, mxb), fmaxf(s0[15], s1[15])); \
        mx = fmaxf(mx, __shfl_xor(mx, 32)); \
        if (__any(mx > mrun)) { \
            const float mn = fmaxf(mrun, mx), alpha = __builtin_amdgcn_exp2f(mrun - mn); mrun = mn; lrun *= alpha; \
            _Pragma("unroll") for (int db = 0; db < NDB; ++db) _Pragma("unroll") for (int r = 0; r < 16; ++r) o[db][r] *= alpha; } \
        s0 = s0 - mrun; s1 = s1 - mrun; \
        _Pragma("unroll") for (int r = 0; r < 16; ++r) { s0[r] = __builtin_amdgcn_exp2f(s0[r]); s1[r] = __builtin_amdgcn_exp2f(s1[r]); } \
        { const f32x16 sm = s0 + s1; \
          lrun += (((sm[0] + sm[1]) + (sm[2] + sm[3])) + ((sm[4] + sm[5]) + (sm[6] + sm[7]))) + (((sm[8] + sm[9]) + (sm[10] + sm[11])) + ((sm[12] + sm[13]) + (sm[14] + sm[15]))); } \
        _Pragma("unroll") for (int c4 = 0; c4 < 4; ++c4) { const int b8 = 8 * (c4 & 1); \
            if (c4 < 2) { pw[c4].x = cvt_pk_bf16(s0[b8 + 0], s0[b8 + 1]); pw[c4].y = cvt_pk_bf16(s0[b8 + 2], s0[b8 + 3]); pw[c4].z = cvt_pk_bf16(s0[b8 + 4], s0[b8 + 5]); pw[c4].w = cvt_pk_bf16(s0[b8 + 6], s0[b8 + 7]); } \
            else        { pw[c4].x = cvt_pk_bf16(s1[b8 + 0], s1[b8 + 1]); pw[c4].y = cvt_pk_bf16(s1[b8 + 2], s1[b8 + 3]); pw[c4].z = cvt_pk_bf16(s1[b8 + 4], s1[b8 + 5]); pw[c4].w = cvt_pk_bf16(s1[b8 + 6], s1[b8 + 7]); } } \
    } \
    ATT_BAR(); \
    if (act) { \
        const LAS unsigned char* vb_ = lds + bcur + KTB + q * VP + hi * 16; \
        _Pragma("unroll") for (int c4 = 0; c4 < 4; ++c4) { \
            const bf16x8 pb = __builtin_bit_cast(bf16x8, pw[c4]); \
            _Pragma("unroll") for (int db = 0; db < NDB; ++db) { \
                const bf16x8 va = *(const LAS bf16x8*)(vb_ + db * 32 * VP + c4 * 32); \
                o[db] = __builtin_amdgcn_mfma_f32_32x32x16_bf16(va, pb, o[db], 0, 0, 0); } } \
    } \
    if (actn) ATT_QK(bnext); \
    ATT_STORE(bfree, KRS, VRS); \
    ATT_BAR(); \
    { const int tmp_ = bcur; bcur = bnext; bnext = bfree; bfree = tmp_; } } while (0)

    ATT_LOAD(0, kra, vra); ATT_LOAD(1, krb, vrb);
    ATT_STORE(0, kra, vra); ATT_STORE(BUF, krb, vrb);
    ATT_LOAD(2, krb, vrb);
    __syncthreads();
    float mrun = -1e30f, lrun = 0.f;
    f32x16 o[NDB];
#pragma unroll
    for (int db = 0; db < NDB; ++db)
#pragma unroll
        for (int r = 0; r < 16; ++r) o[db][r] = 0.f;
    f32x16 s0, s1;
    const f32x16 zacc = {0.f, 0.f, 0.f, 0.f, 0.f, 0.f, 0.f, 0.f, 0.f, 0.f, 0.f, 0.f, 0.f, 0.f, 0.f, 0.f};
    ATT_QK(0);
    if (grpB) ATT_BAR();
    int bcur = 0, bnext = BUF, bfree = 2 * BUF;
#pragma unroll 1
    for (int t = 0; t < NT; t += 2) {
        ATT_STEP(t, kra, vra, krb, vrb);
        ATT_STEP(t + 1, krb, vrb, kra, vra);
    }
    if (!grpB) ATT_BAR();
#undef ATT_BAR
#undef ATT_LOAD
#undef ATT_STORE
#undef ATT_QK
#undef ATT_STEP
    lrun += __shfl_xor(lrun, 32);
    const float inv = 1.f / lrun;
    bf16* orow = Op + (size_t)(q0 + 32 * w + q) * ldo + 4 * hi;
#pragma unroll
    for (int db = 0; db < NDB; ++db)
#pragma unroll
        for (int g = 0; g < 4; ++g) {
            const f32x4 v = {o[db][4 * g] * inv, o[db][4 * g + 1] * inv, o[db][4 * g + 2] * inv, o[db][4 * g + 3] * inv};
            *(v2u*)(orow + 32 * db + 8 * g) = pack4(v);
        }
}

__device__ __forceinline__ void tr_item(const float* W, int Nsrc, int src0, const float* g, bf16* WT, int Kdim, int dst_row0, int k0, LAS float* scr, int lane) {
#pragma unroll 32
    for (int i = 0; i < 32; ++i) { const int kk = 2 * i + (lane >> 5); float v = 0.f; if (src0 >= 0) { v = W[(size_t)(k0 + kk) * Nsrc + src0 + (lane & 31)]; if (g) v *= g[k0 + kk]; } scr[kk * 33 + (lane & 31)] = v; }
    LDS_WAIT(); asm volatile("" ::: "memory");
    const int c = lane & 7;
#pragma unroll
    for (int j = 0; j < 4; ++j) { const int n = (lane >> 3) + 8 * j; const LAS float* s = scr + (8 * c) * 33 + n;
        v4u o; o.x = pk2(s[0 * 33], s[1 * 33]); o.y = pk2(s[2 * 33], s[3 * 33]); o.z = pk2(s[4 * 33], s[5 * 33]); o.w = pk2(s[6 * 33], s[7 * 33]);
        *(v4u*)(WT + (size_t)(dst_row0 + n) * Kdim + k0 + 8 * c) = o; }
    LDS_WAIT(); asm volatile("" ::: "memory");
}
__device__ __forceinline__ int inproj_src(int pc) {
    if (pc < 512) return 672 + pc;
    if (pc < 1024) return 1184 + (pc - 512);
    if (pc < 1536) return 1696 + (pc - 1024);
    if (pc < 3584) return 2208 + (pc - 1536);
    if (pc < 3968) return pc - 3584;
    if (pc < 4224) return 384 + (pc - 3968);
    if (pc < 4256) return 640 + (pc - 4224);
    return -1;
}

typedef unsigned v4u_xb __attribute__((ext_vector_type(4)));
#define XB_TMO      128
#define XB_XCNT(j)  (256  + 64 * (j))
#define XB_XSUB(j)  (1280 + 64 * (j))
#define XB_XGEN(j)  (2304 + 64 * (j))
#define XB_TOP      3328
#define XB_TOPGEN   3392
#define XCD_BAR_WORDS 3456
#define XB_SPIN_CAP (1u << 18)

__device__ __forceinline__ unsigned xb_ld(unsigned* p)              { return __hip_atomic_load(p, __ATOMIC_RELAXED, __HIP_MEMORY_SCOPE_AGENT); }
__device__ __forceinline__ unsigned xb_add(unsigned* p, unsigned v) { return __hip_atomic_fetch_add(p, v, __ATOMIC_RELAXED, __HIP_MEMORY_SCOPE_AGENT); }
__device__ __forceinline__ unsigned xb_xcc_id() { return (unsigned)__builtin_amdgcn_s_getreg((3 << 11) | 20) & 0xFu; }
#define XB_SPIN(cond, bar) do { unsigned _sp = 0; while (cond) { __builtin_amdgcn_s_sleep(1); \
    if ((++_sp & 255u) == 0u) { if (xb_ld(&(bar)[XB_TMO])) break; if (_sp > XB_SPIN_CAP) { atomicAdd(&(bar)[XB_TMO], 1u); break; } } } } while (0)

struct XcdBarrier {
    unsigned* bar; unsigned x;
    volatile LAS unsigned* st;
};

__device__ __forceinline__ XcdBarrier xcd_barrier_post(unsigned* bar, volatile LAS unsigned* st) {
    XcdBarrier b; b.bar = bar; b.x = xb_xcc_id(); b.st = st;
    if (threadIdx.x == 0) (void)xb_add(&bar[XB_XCNT(b.x)], 1u);
    return b;
}
__device__ __forceinline__ void xcd_barrier_complete(unsigned* bar, unsigned x, unsigned& nloc, unsigned& nx) {
    const unsigned G = gridDim.x * gridDim.y * gridDim.z;
    unsigned sum, cnt, mine, sp = 0u;
    for (;;) {
        sum = 0u; cnt = 0u; mine = 0u;
#pragma unroll
        for (unsigned j = 0; j < 16; ++j) { const unsigned c = xb_ld(&bar[XB_XCNT(j)]); sum += c; cnt += (c > 0u) ? 1u : 0u; mine = (j == x) ? c : mine; }
        if (sum == G) break;
        __builtin_amdgcn_s_sleep(1);
        if ((++sp & 255u) == 0u) { if (xb_ld(&bar[XB_TMO])) break; if (sp > XB_SPIN_CAP) { atomicAdd(&bar[XB_TMO], 1u); break; } }
    }
    nloc = mine > 0u ? mine : 1u; nx = cnt > 0u ? cnt : 1u;
}

__device__ __forceinline__ void xcd_barrier(const XcdBarrier& b) {
    asm volatile("s_waitcnt vmcnt(0)" ::: "memory");
    __syncthreads();
    if (threadIdx.x == 0) {
        unsigned* bar = b.bar;
        __builtin_amdgcn_s_waitcnt(0);
        unsigned nloc = b.st[0], nx = b.st[1];
        if (nloc == 0u) { xcd_barrier_complete(bar, b.x, nloc, nx); b.st[0] = nloc; b.st[1] = nx; }
        const unsigned old = xb_add(&bar[XB_XSUB(b.x)], 1u);
        const unsigned gen = old / nloc;
        if (old + 1u == (gen + 1u) * nloc) {
            __builtin_amdgcn_fence(__ATOMIC_RELEASE, "agent");
            asm volatile("s_waitcnt vmcnt(0)" ::: "memory");
            const unsigned og = xb_add(&bar[XB_TOP], 1u);
            const unsigned tg = og / nx;
            if (og + 1u == (tg + 1u) * nx) xb_add(&bar[XB_TOPGEN], 1u);
            else XB_SPIN(xb_ld(&bar[XB_TOPGEN]) == tg, bar);
            __builtin_amdgcn_fence(__ATOMIC_ACQUIRE, "agent");
            xb_add(&bar[XB_XGEN(b.x)], 1u);
            asm volatile("s_waitcnt vmcnt(0)" ::: "memory");
        } else {
            XB_SPIN(xb_ld(&bar[XB_XGEN(b.x)]) == gen, bar);
            __builtin_amdgcn_fence(__ATOMIC_ACQUIRE, "agent");
            asm volatile("s_waitcnt vmcnt(0)" ::: "memory");
        }
    }
    __syncthreads();
}

#define GRID_SYNC() xcd_barrier(xbar)
struct Args {
    const float* x; const int* positions; const float *norm_mix_g, *w_in, *b_gate, *mla_q_norm_g, *mla_w_uq, *mla_kv_norm_g, *mla_w_ukv;
    const float *lq1, *lk1, *lq2, *lk2, *subln_g, *w_branch_mla, *w_branch_diff, *w_out, *norm_ffn_g, *w_ffn_gate, *w_ffn_up, *w_ffn_down, *norm_final_g;
    float* out; unsigned char* ws;
};

__global__ void __launch_bounds__(512, 2) fwd_megakernel(Args a) {
    extern __shared__ __attribute__((aligned(16))) unsigned char lds_raw[];
    LAS unsigned char* lds = (LAS unsigned char*)lds_raw;
    cg::grid_group grid = cg::this_grid();
    const int tid = threadIdx.x, lane = tid & 63, wave = __builtin_amdgcn_readfirstlane(tid >> 6);
    const int G = gridDim.x, bx = blockIdx.x;
    const int vcu = (G % 8 == 0) ? (bx % 8) * (G / 8) + bx / 8 : bx;
    const int gw = vcu * 8 + wave, NGW = G * 8;
    unsigned char* ws = a.ws;
    for (int u_ = tid; u_ < 64; u_ += 512) ((LAS unsigned*)(lds + 131072))[u_] = 0u;
    __syncthreads();
    grid.sync();
    XcdBarrier xbar = xcd_barrier_post((unsigned*)(ws + WS_SS) + 4096, (volatile LAS unsigned*)(lds + 131072 + 32));
    float* ssq = (float*)(ws + WS_PART); float* sskv = ssq + (size_t)M * 16; float* ss1 = sskv + (size_t)M * 16; float* ss2 = ss1 + (size_t)M * 16;
    float* tdc = (float*)(ws + WS_TAB); float* tds = tdc + (size_t)M * 8; float* tmc = tds + (size_t)M * 8; float* tms = tmc + (size_t)M * 16;
    bf16 *W1 = (bf16*)(ws + WS_W1), *W2A = (bf16*)(ws + WS_W2A), *W2B = (bf16*)(ws + WS_W2B), *W3A = (bf16*)(ws + WS_W3A), *W3B = (bf16*)(ws + WS_W3B), *W4 = (bf16*)(ws + WS_W4), *W5 = (bf16*)(ws + WS_W5), *W6 = (bf16*)(ws + WS_W6);
    bf16 *XN = (bf16*)(ws + WS_XN), *QL = (bf16*)(ws + WS_QL), *KVL = (bf16*)(ws + WS_KVL), *OM = (bf16*)(ws + WS_OM), *ODR = (bf16*)(ws + WS_ODR);
    bf16 *QD = (bf16*)(ws + WS_QD), *ODN = (bf16*)(ws + WS_ODN), *KD = (bf16*)(ws + WS_KD), *VDT = (bf16*)(ws + WS_VDT), *MERGED = (bf16*)(ws + WS_MERGED);
    bf16 *QM = (bf16*)(ws + WS_QM), *KM = (bf16*)(ws + WS_KM), *VMT = (bf16*)(ws + WS_VMT), *X1B = (bf16*)(ws + WS_X1B), *HB = (bf16*)(ws + WS_H);
    float* TMP = (float*)(ws + WS_TMP);
    bf16* GATES = (bf16*)a.out;

    if (PH(0)) {
        LAS float* scr = (LAS float*)(lds + wave * 16384);
        constexpr int I1 = 16 * (N1 / 32), I2A = 6 * 24, I2B = 4 * 32, I3 = 8 * 32, I4 = 16 * 32, I5 = 16 * (2 * FF / 32), I6 = (FF / 64) * 32;
        constexpr int NITEMS = I1 + I2A + I2B + 2 * I3 + I4 + I5 + I6;
        for (int it = gw; it < I1; it += NGW) { const int nb = it % (N1 / 32), kb = it / (N1 / 32); tr_item(a.w_in, 4256, inproj_src(32 * nb), nullptr, W1, 1024, 32 * nb, 64 * kb, scr, lane); }
        for (int m = gw; m < M; m += 2 * NGW) {
            const int m2 = m + NGW < M ? m + NGW : m;
            const f32x4* xr = (const f32x4*)(a.x + (size_t)m * D) + lane; const f32x4* xr2 = (const f32x4*)(a.x + (size_t)m2 * D) + lane; const f32x4* gr = (const f32x4*)a.norm_mix_g + lane;
            f32x4 v[4], v2[4]; float s = 0.f, s2 = 0.f;
#pragma unroll
            for (int j = 0; j < 4; ++j) { v[j] = xr[64 * j]; v2[j] = xr2[64 * j]; }
#pragma unroll
            for (int j = 0; j < 4; ++j) { s += (v[j][0] * v[j][0] + v[j][1] * v[j][1]) + (v[j][2] * v[j][2] + v[j][3] * v[j][3]); s2 += (v2[j][0] * v2[j][0] + v2[j][1] * v2[j][1]) + (v2[j][2] * v2[j][2] + v2[j][3] * v2[j][3]); }
            const float rs = rsqrtf(wave_sum(s) * (1.f / D) + EPS), rs2 = rsqrtf(wave_sum(s2) * (1.f / D) + EPS);
            v2u* o8 = (v2u*)(XN + (size_t)m * D) + lane; v2u* o82 = (v2u*)(XN + (size_t)m2 * D) + lane;
#pragma unroll
            for (int j = 0; j < 4; ++j) { const f32x4 g = gr[64 * j]; o8[64 * j] = pack4(v[j] * rs * g); o82[64 * j] = pack4(v2[j] * rs2 * g); }
        }
        const int gt = vcu * 512 + tid, NGT = G * 512;
        for (int i = gt; i < M * 24; i += NGT) {
            const int tok = i / 24, f = i % 24; const float pos = (float)a.positions[tok];
            const bool dm = f >= 8; const int fi = dm ? f - 8 : f;
            const float inv = expf((-13.122363377404328f * (float)fi) * (dm ? (2.0f / 32.0f) : (2.0f / 16.0f)));
            const float ang = pos * inv;
            const double ad = (double)ang, kd = rint(ad * 0.15915494309189535), rd = ad - kd * 6.283185307179586;
            const float rr = (float)rd, cs = __cosf(rr), sn = __sinf(rr);
            if (dm) { tmc[(size_t)tok * 16 + fi] = cs; tms[(size_t)tok * 16 + fi] = sn; } else { tdc[(size_t)tok * 8 + fi] = cs; tds[(size_t)tok * 8 + fi] = sn; }
        }
    }
    GRID_SYNC();

    if (PH(1)) {
        pg8::Gemm g{XN, W1, M, N1, D}; pg8::StaticOrder S; S.init(M, N1, G, bx);
        EpiInProj E{QD, KD, VDT, GATES, QL, KVL, KM, a.b_gate, tdc, tds, tmc, tms, ssq, sskv};
        pg8::gemm_phase<EpiInProj, pg8::StaticOrder, true, true>(lds, g, S, E);
        {
            constexpr int I1 = 16 * (N1 / 32), I2A = 6 * 24, I2B = 4 * 32, I3 = 8 * 32, I4 = 16 * 32, I5 = 16 * (2 * FF / 32), I6 = (FF / 64) * 32;
            constexpr int NITEMS = I1 + I2A + I2B + 2 * I3 + I4 + I5 + I6;
            const int nextra = ((M / 256) * (N1 / 256)) % G;
            const int first = (nextra * 4 <= G) ? nextra : 0;
            if (bx >= first) {
                LAS float* scr = (LAS float*)(lds + wave * 16384);
                const int dgw = (bx - first) * 8 + wave, DNGW = (G - first) * 8;
        for (int it = I1 + dgw; it < NITEMS; it += DNGW) {
            int r = it;
            if (r < I1) { const int nb = r % (N1 / 32), kb = r / (N1 / 32); tr_item(a.w_in, 4256, inproj_src(32 * nb), nullptr, W1, 1024, 32 * nb, 64 * kb, scr, lane); continue; } r -= I1;
            if (r < I2A) { const int nb = r % 24, kb = r / 24; tr_item(a.mla_w_uq, 768, 32 * nb, a.mla_q_norm_g, W2A, 384, 32 * nb, 64 * kb, scr, lane); continue; } r -= I2A;
            if (r < I2B) { const int nb = r % 32, kb = r / 32; tr_item(a.mla_w_ukv, 1024, 32 * nb, a.mla_kv_norm_g, W2B, 256, 32 * nb, 64 * kb, scr, lane); continue; } r -= I2B;
            if (r < I3) { const int nb = r % 32, kb = r / 32; tr_item(a.w_branch_mla, 1024, 32 * nb, nullptr, W3A, 512, 32 * nb, 64 * kb, scr, lane); continue; } r -= I3;
            if (r < I3) { const int nb = r % 32, kb = r / 32; tr_item(a.w_branch_diff, 1024, 32 * nb, nullptr, W3B, 512, 32 * nb, 64 * kb, scr, lane); continue; } r -= I3;
            if (r < I4) { const int nb = r % 32, kb = r / 32; tr_item(a.w_out, 1024, 32 * nb, nullptr, W4, 1024, 32 * nb, 64 * kb, scr, lane); continue; } r -= I4;
            if (r < I5) { const int nb = r % (2 * FF / 32), kb = r / (2 * FF / 32); const int pc = 32 * nb, tile = pc >> 8, inner = pc & 255;
                const float* W = inner < 128 ? a.w_ffn_gate : a.w_ffn_up; tr_item(W, FF, 128 * tile + (inner & 127), a.norm_ffn_g, W5, 1024, pc, 64 * kb, scr, lane); continue; } r -= I5;
            { const int nb = r % 32, kb = r / 32; tr_item(a.w_ffn_down, 1024, 32 * nb, nullptr, W6, FF, 32 * nb, 64 * kb, scr, lane); }
        }
            }
        }
    }
    GRID_SYNC();

    if (PH(2)) {
        pg8::Gemm g{KVL, W2B, M, 1024, 256}; pg8::StaticOrder S; S.init(M, 1024, G, bx);
        EpiKVup E{KM, VMT, sskv};
        pg8::gemm_phase<EpiKVup, pg8::StaticOrder, true, true>(lds, g, S, E);
    }
    __syncthreads();
    if (PH(3)) {
        pg8::Gemm g{QL, W2A, M, 768, 384}; pg8::StaticOrder S; S.init(M, 768, G, bx);
        EpiQup E{QM, ssq, tmc, tms};
        pg8::gemm_phase<EpiQup, pg8::StaticOrder, true, true>(lds, g, S, E);
    }
    GRID_SYNC();

    if (PH(4)) {
#pragma unroll 1
        for (int j = vcu; j < 512; j += G) {
            const int i = j >> 8, v = j & 255, bh = v >> 4, s = v & 15;
            const int b = bh >> 3, h = bh & 7, qb = (i == 0) ? s : 31 - s;
            attn_unit<96, 64>(lds, QM + (size_t)b * SEQ * 768 + h * 96, 768, KM + (size_t)b * SEQ * 768 + h * 96, 768, VMT + (size_t)(b * 8 + h) * 64 * SEQ, OM + (size_t)b * SEQ * 512 + h * 64, 512, qb);
        }
#pragma unroll 1
        for (int j = 512 + vcu; j < 1024; j += G) {
            const int i = j >> 8, v = j & 255, bh = v >> 4, s = v & 15;
            const int b = bh >> 3, h = (bh >> 1) & 3, c = bh & 1, qb = (i == 2) ? 15 - s : 16 + s;
            attn_unit<64, 128>(lds, QD + (size_t)b * SEQ * 512 + (h * 2 + c) * 64, 512, KD + (size_t)b * SEQ * 512 + (h * 2 + c) * 64, 512, VDT + (size_t)(b * 4 + h) * 128 * SEQ, ODR + (size_t)b * SEQ * 1024 + (h * 2 + c) * 128, 1024, qb);
        }
    }
    GRID_SYNC();

    if (PH(5)) {
        pg8::Gemm g{OM, W3A, M, D, 512}; pg8::StaticOrder S; S.init(M, D, G, bx);
        EpiBranch<0> E{GATES, TMP, MERGED};
        pg8::gemm_phase<EpiBranch<0>, pg8::StaticOrder, true, true>(lds, g, S, E);
    }
    if (PH(6)) {
        const float d1 = wave_sum(a.lq1[lane] * a.lk1[lane]), d2 = wave_sum(a.lq2[lane] * a.lk2[lane]);
        const float lam = expf(d1) - expf(d2) + LAMBDA_INIT;
        f32x4 g0 = *(const f32x4*)(a.subln_g + 8 * (lane & 15)), g1 = *(const f32x4*)(a.subln_g + 8 * (lane & 15) + 4);
        g0 = g0 * (1.f - LAMBDA_INIT); g1 = g1 * (1.f - LAMBDA_INIT);
        for (int m = gw; m < M; m += NGW) {
            const int h = lane >> 4, dd = 8 * (lane & 15);
            const v4u w1 = *(const v4u*)(ODR + (size_t)m * 1024 + h * 256 + dd), w2 = *(const v4u*)(ODR + (size_t)m * 1024 + h * 256 + 128 + dd);
            float v[8];
#pragma unroll
            for (int k = 0; k < 4; ++k) { v[2 * k] = bf2f(w1[k] & 0xffffu) - lam * bf2f(w2[k] & 0xffffu); v[2 * k + 1] = bf2f(w1[k] >> 16) - lam * bf2f(w2[k] >> 16); }
            float s = 0.f;
#pragma unroll
            for (int k = 0; k < 8; ++k) s += v[k] * v[k];
            s += __shfl_xor(s, 1); s += __shfl_xor(s, 2); s += __shfl_xor(s, 4); s += __shfl_xor(s, 8);
            const float rs = rsqrtf(s * (1.f / 128.f) + EPS);
            const f32x4 o0 = {v[0] * rs * g0[0], v[1] * rs * g0[1], v[2] * rs * g0[2], v[3] * rs * g0[3]}, o1 = {v[4] * rs * g1[0], v[5] * rs * g1[1], v[6] * rs * g1[2], v[7] * rs * g1[3]};
            *(v4u*)(ODN + (size_t)m * 512 + h * 128 + dd) = pack8(o0, o1);
        }
    }
    GRID_SYNC();

    if (PH(7)) {
        pg8::Gemm g{ODN, W3B, M, D, 512}; pg8::StaticOrder S; S.init(M, D, G, bx);
        EpiBranch<1> E{GATES, TMP, MERGED};
        pg8::gemm_phase<EpiBranch<1>, pg8::StaticOrder, true, true>(lds, g, S, E);
    }
    GRID_SYNC();

    if (PH(8)) {
        pg8::Gemm g{MERGED, W4, M, D, D}; pg8::StaticOrder S; S.init(M, D, G, bx);
        EpiRes E{a.x, a.out, X1B, ss1};
        pg8::gemm_phase<EpiRes, pg8::StaticOrder, true, true>(lds, g, S, E);
    }
    GRID_SYNC();

    if (PH(9)) {
        pg8::Gemm g{X1B, W5, M, 2 * FF, D}; pg8::StaticOrder S; S.init(M, 2 * FF, G, bx);
        EpiSwiglu E{HB, ss1};
        pg8::gemm_phase<EpiSwiglu, pg8::StaticOrder, true, true>(lds, g, S, E);
    }
    GRID_SYNC();

    if (PH(10)) {
        pg8::Gemm g{HB, W6, M, D, FF}; pg8::StaticOrder S; S.init(M, D, G, bx);
        EpiRes E{a.out, a.out, nullptr, ss2};
        pg8::gemm_phase<EpiRes, pg8::StaticOrder, true, true>(lds, g, S, E);
    }
    GRID_SYNC();

    if (PH(11)) for (int m = gw; m < M; m += 2 * NGW) {
        const int m2 = m + NGW < M ? m + NGW : m;
        f32x4* xr = (f32x4*)(a.out + (size_t)m * D) + lane; f32x4* xr2 = (f32x4*)(a.out + (size_t)m2 * D) + lane; const f32x4* gr = (const f32x4*)a.norm_final_g + lane;
        float sq = ss2[(size_t)m * 16 + (lane & 15)], sq2 = ss2[(size_t)m2 * 16 + (lane & 15)];
        f32x4 v[4], v2[4];
#pragma unroll
        for (int j = 0; j < 4; ++j) { v[j] = xr[64 * j]; v2[j] = xr2[64 * j]; }
        sq += __shfl_xor(sq, 1); sq += __shfl_xor(sq, 2); sq += __shfl_xor(sq, 4); sq += __shfl_xor(sq, 8);
        sq2 += __shfl_xor(sq2, 1); sq2 += __shfl_xor(sq2, 2); sq2 += __shfl_xor(sq2, 4); sq2 += __shfl_xor(sq2, 8);
        const float rs = rsqrtf(sq * (1.f / D) + EPS), rs2 = rsqrtf(sq2 * (1.f / D) + EPS);
#pragma unroll
        for (int j = 0; j < 4; ++j) { const f32x4 g = gr[64 * j]; xr[64 * j] = v[j] * rs * g; if (m2 != m) xr2[64 * j] = v2[j] * rs2 * g; }
    }
}

extern "C" void kernel_launch(void* const* d_in, const int* in_sizes, int n_in, void* d_out, int out_size, void* d_ws, size_t ws_size, hipStream_t stream) {
    static int grid = 0;
    if (grid == 0) {
        if (n_in != 22 || in_sizes[0] != M * D || out_size != M * D || ws_size < WS_END) { fprintf(stderr, "kernel_launch: unexpected shapes (n_in %d, ws %zu)\n", n_in, ws_size); grid = -1; return; }
        int dev = 0, cus = 0, per_cu = 0;
        hipGetDevice(&dev); hipDeviceGetAttribute(&cus, hipDeviceAttributeMultiprocessorCount, dev);
        hipFuncSetAttribute((const void*)fwd_megakernel, hipFuncAttributeMaxDynamicSharedMemorySize, LDS_BYTES);
        hipOccupancyMaxActiveBlocksPerMultiprocessor(&per_cu, (const void*)fwd_megakernel, 512, LDS_BYTES);
        if (per_cu < 1) { fprintf(stderr, "kernel_launch: occupancy query says %d blocks per CU\n", per_cu); per_cu = 1; }
        grid = cus * (per_cu > 1 ? 1 : per_cu);
        (void)hipGetLastError();
    }
    if (grid < 0) return;
    if (hipMemsetAsync(d_ws, 0, 65536, stream) != hipSuccess) { fprintf(stderr, "kernel_launch: memset failed\n"); return; }
    Args a{};
    a.x = (const float*)d_in[0]; a.positions = (const int*)d_in[1]; a.norm_mix_g = (const float*)d_in[2]; a.w_in = (const float*)d_in[3]; a.b_gate = (const float*)d_in[4];
    a.mla_q_norm_g = (const float*)d_in[5]; a.mla_w_uq = (const float*)d_in[6]; a.mla_kv_norm_g = (const float*)d_in[7]; a.mla_w_ukv = (const float*)d_in[8];
    a.lq1 = (const float*)d_in[9]; a.lk1 = (const float*)d_in[10]; a.lq2 = (const float*)d_in[11]; a.lk2 = (const float*)d_in[12]; a.subln_g = (const float*)d_in[13];
    a.w_branch_mla = (const float*)d_in[14]; a.w_branch_diff = (const float*)d_in[15]; a.w_out = (const float*)d_in[16]; a.norm_ffn_g = (const float*)d_in[17];
    a.w_ffn_gate = (const float*)d_in[18]; a.w_ffn_up = (const float*)d_in[19]; a.w_ffn_down = (const float*)d_in[20]; a.norm_final_g = (const float*)d_in[21];
    a.out = (float*)d_out; a.ws = (unsigned char*)d_ws;
    void* args[] = {&a};
    hipError_t e = hipLaunchCooperativeKernel((const void*)fwd_megakernel, dim3(grid), dim3(512), args, LDS_BYTES, stream);
    if (e != hipSuccess) fprintf(stderr, "cooperative launch failed: %s (grid %d)\n", hipGetErrorString(e), grid);
}
```
